# Optimizing an MI355X kernel written in HIP

```python
import jax, jax.numpy as jnp
from jax import lax
import numpy as np

D_MODEL = 1024
BATCH = 8
SEQ = 4096
DEPTH = 1

CHUNK = 64
Q_BLOCK = 128

MIX_WIDTH = D_MODEL
GLA_WIDTH = MIX_WIDTH // 2
DSA_WIDTH = MIX_WIDTH - GLA_WIDTH

GLA_HEADS = 4
GLA_DV = GLA_WIDTH // GLA_HEADS
GLA_DK = GLA_DV // 2
GLA_QK = GLA_HEADS * GLA_DK
GLA_LOWRANK = 16
GLA_TAU = 16.0

DSA_HEADS = 8
DSA_DH = DSA_WIDTH // DSA_HEADS
IDX_HEADS = 8
IDX_DIM = 64
TOPK_MAX = 256

D_FF = 2816

LN_EPS = 1e-5
RMS_EPS = 1e-6
DEEPNORM_ALPHA = (2.0 * DEPTH) ** 0.25
DEEPNORM_BETA = (8.0 * DEPTH) ** -0.25

IN_SPLITS = (GLA_QK, GLA_QK, GLA_WIDTH, GLA_WIDTH, GLA_LOWRANK,
             DSA_WIDTH, DSA_WIDTH, DSA_WIDTH, IDX_HEADS * IDX_DIM, IDX_DIM, IDX_HEADS)
IN_TOTAL = 2 * GLA_QK + 2 * GLA_WIDTH + GLA_LOWRANK + 3 * DSA_WIDTH + IDX_HEADS * IDX_DIM + IDX_DIM + IDX_HEADS

kernel_name = "hymba_gla_dsa_macaron_deepnorm"


def layer_norm(x, g, b):
    xf = x.astype(jnp.float32)
    mu = jnp.mean(xf, axis=-1, keepdims=True)
    xc = xf - mu
    var = jnp.mean(xc * xc, axis=-1, keepdims=True)
    return (xc * lax.rsqrt(var + LN_EPS) * g + b).astype(x.dtype)


def swiglu_ffn(x, w_gu, w_down):
    gu = x @ w_gu
    g, u = jnp.split(gu, 2, axis=-1)
    return (jax.nn.silu(g) * u) @ w_down


def gla_chunked(q, k, v, log_a):
    B, T, H, dk = q.shape
    dv = v.shape[-1]
    n = T // CHUNK

    def to_chunks(t):
        return t.reshape(B, n, CHUNK, H, t.shape[-1]).transpose(1, 0, 3, 2, 4)

    qc, kc, vc, ac = to_chunks(q), to_chunks(k), to_chunks(v), to_chunks(log_a)
    causal = jnp.tril(jnp.ones((CHUNK, CHUNK), dtype=bool))

    def step(S, inp):
        qn, kn, vn, an = inp
        b = jnp.cumsum(an, axis=-2)
        b_last = b[:, :, -1:, :]
        diff = b[:, :, :, None, :] - b[:, :, None, :, :]
        diff = jnp.where(causal[None, None, :, :, None], diff, -jnp.inf)
        A = jnp.einsum('bhid,bhjd,bhijd->bhij', qn, kn, jnp.exp(diff))
        o = jnp.einsum('bhij,bhjv->bhiv', A, vn) + jnp.einsum('bhid,bhdv->bhiv', qn * jnp.exp(b), S)
        S_new = jnp.exp(b_last[:, :, 0, :])[..., None] * S + jnp.einsum(
            'bhjd,bhjv->bhdv', kn * jnp.exp(b_last - b), vn)
        return S_new, o

    S0 = jnp.zeros((B, H, dk, dv), jnp.float32)
    _, o = lax.scan(step, S0, (qc, kc, vc, ac))
    return o.transpose(1, 0, 3, 2, 4).reshape(B, T, H, dv)


def dsa_attention(q, k, v, q_idx, k_idx, w_idx):
    B, T, H, Dh = q.shape
    topk = min(TOPK_MAX, T // 4)
    nb = T // Q_BLOCK
    key_chunk = jnp.arange(T) // CHUNK
    k_idx32 = k_idx.astype(jnp.float32)
    scale = Dh ** -0.5

    def to_blocks(t):
        return jnp.moveaxis(t.reshape((B, nb, Q_BLOCK) + t.shape[2:]), 1, 0)

    def gather_rows(table, idx):
        return jax.vmap(lambda tb, ib: tb[ib])(table, idx)

    def block(args):
        qb, qib, wb, start = args
        q_chunk = (start + jnp.arange(Q_BLOCK)) // CHUNK
        adm = key_chunk[None, :] <= q_chunk[:, None]
        s = jax.nn.relu(jnp.einsum('bqhd,bsd->bqhs', qib.astype(jnp.float32), k_idx32))
        score = jnp.einsum('bqh,bqhs->bqs', wb.astype(jnp.float32), s)
        score = jnp.where(adm[None], score, -jnp.inf)
        _, idx = lax.top_k(score, topk)
        valid = key_chunk[idx] <= q_chunk[None, :, None]
        kg = gather_rows(k, idx)
        vg = gather_rows(v, idx)
        logits = jnp.einsum('bqhd,bqkhd->bqhk', qb, kg).astype(jnp.float32) * scale
        logits = jnp.where(valid[:, :, None, :], logits, -jnp.inf)
        p = jax.nn.softmax(logits, axis=-1)
        return jnp.einsum('bqhk,bqkhd->bqhd', p.astype(vg.dtype), vg)

    starts = jnp.arange(nb) * Q_BLOCK
    out = lax.map(block, (to_blocks(q), to_blocks(q_idx), to_blocks(w_idx), starts))
    return jnp.moveaxis(out, 0, 1).reshape(B, T, H * Dh)


def hybrid_mixer(h, w_in, w_gla_a2, b_gla_a, gla_norm_g, w_out):
    B, T, _ = h.shape
    f32 = jnp.float32
    proj = h @ w_in
    offs = [int(o) for o in np.cumsum(IN_SPLITS)[:-1]]
    gq, gk, gv, gg, ga, dq, dk, dv, iq, ik, iw = jnp.split(proj, offs, axis=-1)

    q = gq.astype(f32).reshape(B, T, GLA_HEADS, GLA_DK) * (GLA_DK ** -0.5)
    k = gk.astype(f32).reshape(B, T, GLA_HEADS, GLA_DK)
    v = gv.astype(f32).reshape(B, T, GLA_HEADS, GLA_DV)
    log_a = (jax.nn.log_sigmoid((ga @ w_gla_a2 + b_gla_a).astype(f32)) / GLA_TAU).reshape(B, T, GLA_HEADS, GLA_DK)
    o = gla_chunked(q, k, v, log_a)
    o = o * lax.rsqrt(jnp.mean(o * o, axis=-1, keepdims=True) + RMS_EPS) * gla_norm_g.astype(f32)
    o_gla = (o.reshape(B, T, GLA_WIDTH) * jax.nn.silu(gg.astype(f32))).astype(h.dtype)

    o_dsa = dsa_attention(
        dq.reshape(B, T, DSA_HEADS, DSA_DH),
        dk.reshape(B, T, DSA_HEADS, DSA_DH),
        dv.reshape(B, T, DSA_HEADS, DSA_DH),
        iq.reshape(B, T, IDX_HEADS, IDX_DIM) * (IDX_DIM ** -0.5),
        ik,
        iw * (IDX_HEADS ** -0.5),
    ).astype(h.dtype)

    return jnp.concatenate([o_gla, o_dsa], axis=-1) @ w_out


def setup_inputs(seed: int = 0) -> dict:
    key = jax.random.key(seed)
    ks = jax.random.split(key, 17)
    nrm = lambda k, shape, fan_in, gain=1.0: jax.random.normal(k, shape, jnp.float32) * (gain * fan_in ** -0.5)
    return {
        "x": jax.random.normal(ks[0], (BATCH, SEQ, D_MODEL), jnp.float32),
        "w_in": nrm(ks[1], (DEPTH, D_MODEL, IN_TOTAL), D_MODEL),
        "w_gla_a2": nrm(ks[2], (DEPTH, GLA_LOWRANK, GLA_QK), GLA_LOWRANK),
        "b_gla_a": 0.1 * jax.random.normal(ks[3], (DEPTH, GLA_QK), jnp.float32),
        "gla_norm_g": 1.0 + 0.02 * jax.random.normal(ks[4], (DEPTH, GLA_DV), jnp.float32),
        "w_out": nrm(ks[5], (DEPTH, MIX_WIDTH, D_MODEL), MIX_WIDTH, DEEPNORM_BETA),
        "ffn1_w_gu": nrm(ks[6], (DEPTH, D_MODEL, 2 * D_FF), D_MODEL),
        "ffn1_w_down": nrm(ks[7], (DEPTH, D_FF, D_MODEL), D_FF, DEEPNORM_BETA),
        "ffn2_w_gu": nrm(ks[8], (DEPTH, D_MODEL, 2 * D_FF), D_MODEL),
        "ffn2_w_down": nrm(ks[9], (DEPTH, D_FF, D_MODEL), D_FF, DEEPNORM_BETA),
        "ln1_g": 1.0 + 0.02 * jax.random.normal(ks[10], (DEPTH, D_MODEL), jnp.float32),
        "ln1_b": 0.02 * jax.random.normal(ks[11], (DEPTH, D_MODEL), jnp.float32),
        "ln2_g": 1.0 + 0.02 * jax.random.normal(ks[12], (DEPTH, D_MODEL), jnp.float32),
        "ln2_b": 0.02 * jax.random.normal(ks[13], (DEPTH, D_MODEL), jnp.float32),
        "ln3_g": 1.0 + 0.02 * jax.random.normal(ks[14], (DEPTH, D_MODEL), jnp.float32),
        "ln3_b": 0.02 * jax.random.normal(ks[15], (DEPTH, D_MODEL), jnp.float32),
    }


def reference(x, w_in, w_gla_a2, b_gla_a, gla_norm_g, w_out, ffn1_w_gu, ffn1_w_down,
              ffn2_w_gu, ffn2_w_down, ln1_g, ln1_b, ln2_g, ln2_b, ln3_g, ln3_b):
    for l in range(DEPTH):
        x = layer_norm(DEEPNORM_ALPHA * x + 0.5 * swiglu_ffn(x, ffn1_w_gu[l], ffn1_w_down[l]), ln1_g[l], ln1_b[l])
        x = layer_norm(DEEPNORM_ALPHA * x + hybrid_mixer(x, w_in[l], w_gla_a2[l], b_gla_a[l], gla_norm_g[l], w_out[l]),
                       ln2_g[l], ln2_b[l])
        x = layer_norm(DEEPNORM_ALPHA * x + 0.5 * swiglu_ffn(x, ffn2_w_gu[l], ffn2_w_down[l]), ln3_g[l], ln3_b[l])
    return x
```

```cpp
#include <hip/hip_runtime.h>
#include <hip/hip_cooperative_groups.h>
#include <cstdio>
#include <cstdint>
namespace cg = cooperative_groups;
namespace pg8 {
#define PG8_LAS __attribute__((address_space(3)))
typedef unsigned short bf16_t;
typedef short bf16x8 __attribute__((ext_vector_type(8)));
typedef float f32x4 __attribute__((ext_vector_type(4)));
typedef unsigned u32x4 __attribute__((ext_vector_type(4)));
constexpr int BM = 256, BK = 64, HALF = 128, HTB = HALF * BK * 2  , STAGE_BYTES = 8 * HTB, NXCD = 8, WGM = 8;

__host__ __device__ __forceinline__ int lds_byte(int r, int c) { const int st = (r >> 4) * 2 + (c >> 5), rr = r & 15, cc = c & 31, ob = rr * 64 + cc * 2; return st * 1024 + (ob ^ (((ob >> 9) & 1) << 5)); }
__host__ __device__ __forceinline__ void stage_rc(int b, int& R, int& C) { const int st = b / 1024, sb = b % 1024, swz = sb ^ (((sb >> 9) & 1) << 5); R = (st >> 1) * 16 + swz / 64; C = (st & 1) * 32 + (swz % 64) / 2; }
__host__ __device__ __forceinline__ int perm32(int rho) { const int n = rho >> 4, i = rho & 15; return 8 * (i >> 2) + 4 * n + (i & 3); }

struct Unit { int pm, pn; };
struct Gemm { const bf16_t* A; const bf16_t* Bt; int M, N, K; };

struct StaticOrder {
    int nM, nN, nwg, G, c;
    __host__ __device__ void init(int M, int N, int G_, int c_) { nM = M / BM; nN = N / BM; nwg = nM * nN; G = G_; c = c_; }
    __host__ __device__ bool next(int i, Unit& u) const {
        const long L = (long)i * G + c; if (L >= nwg) return false;
        int wgid = (int)L; { const int q = nwg / NXCD, r = nwg % NXCD, xcd = wgid % NXCD, off = wgid / NXCD; wgid = (xcd < r ? xcd * (q + 1) : r * (q + 1) + (xcd - r) * q) + off; }
        const int nig = WGM * nN, gid = wgid / nig, fm = gid * WGM, gsz = (nM - fm) < WGM ? (nM - fm) : WGM;
        u.pm = fm + ((wgid % nig) % gsz); u.pn = (wgid % nig) / gsz; return true;
    }
    __device__ __forceinline__ void a_ready(const Unit&) const {}
    __device__ __forceinline__ void done(const Unit&) const {}
};

__device__ __forceinline__ unsigned cvt_pk_bf16(float lo, float hi) { unsigned r; asm volatile("v_cvt_pk_bf16_f32 %0, %1, %2" : "=v"(r) : "v"(lo), "v"(hi)); return r; }
typedef float f32x2 __attribute__((ext_vector_type(2)));
__device__ __forceinline__ float silu_f(float g) { return g * __builtin_amdgcn_rcpf(1.0f + __expf(-g)); }
struct EpiSwiglu {
    static constexpr bool PERM = true, AFTER_DRAIN = false;
    bf16_t* O; int ldc;
    __device__ __forceinline__ void operator()(const f32x4 (&acc)[2][2][4][2], const Unit& u, int wr, int wc, int fr, int fq) const {
        const int row0 = u.pm * BM + wr * 64 + fr, col0 = u.pn * HALF + wc * 32 + 8 * fq;
#pragma unroll
        for (int ai = 0; ai < 2; ++ai)
#pragma unroll
            for (int m = 0; m < 4; ++m) { bf16_t* rowp = O + (size_t)(row0 + ai * HALF + m * 16) * ldc + col0;
                const f32x4 g0 = acc[ai][0][m][0], g1 = acc[ai][0][m][1], u0 = acc[ai][1][m][0], u1 = acc[ai][1][m][1];
                u32x4 w; w.x = cvt_pk_bf16(silu_f(g0[0]) * u0[0], silu_f(g0[1]) * u0[1]); w.y = cvt_pk_bf16(silu_f(g0[2]) * u0[2], silu_f(g0[3]) * u0[3]);
                w.z = cvt_pk_bf16(silu_f(g1[0]) * u1[0], silu_f(g1[1]) * u1[1]); w.w = cvt_pk_bf16(silu_f(g1[2]) * u1[2], silu_f(g1[3]) * u1[3]);
                *(u32x4*)rowp = w; }
    }
};
struct EpiResF32 {
    static constexpr bool PERM = false, AFTER_DRAIN = false;
    const float* R; float* Y; int ldc; float alpha, scale;
    __device__ __forceinline__ void operator()(const f32x4 (&acc)[2][2][4][2], const Unit& u, int wr, int wc, int fr, int fq) const {
        const int col0 = u.pn * BM + wc * 32 + 4 * fq;
#pragma unroll
        for (int ai = 0; ai < 2; ++ai)
#pragma unroll
            for (int m = 0; m < 4; ++m) { const size_t off = (size_t)(u.pm * BM + ai * HALF + wr * 64 + m * 16 + fr) * ldc + col0;
#pragma unroll
                for (int bj = 0; bj < 2; ++bj)
#pragma unroll
                    for (int n = 0; n < 2; ++n) { const f32x4 r = *(const f32x4*)(R + off + bj * HALF + n * 16);
                        *(f32x4*)(Y + off + bj * HALF + n * 16) = r * alpha + acc[ai][bj][m][n] * scale; } }
    }
};
struct EpiProj {
    static constexpr bool PERM = true, AFTER_DRAIN = false;
    bf16_t* O; int ldc; float* PM; int misc_pn;
    __device__ __forceinline__ void operator()(const f32x4 (&acc)[2][2][4][2], const Unit& u, int wr, int wc, int fr, int fq) const {
        const int row0 = u.pm * BM + wr * 64 + fr, col0 = u.pn * BM + wc * 32 + 8 * fq;
#pragma unroll
        for (int ai = 0; ai < 2; ++ai)
#pragma unroll
            for (int m = 0; m < 4; ++m) { const int row = row0 + ai * HALF + m * 16; bf16_t* rowp = O + (size_t)row * ldc + col0;
#pragma unroll
                for (int bj = 0; bj < 2; ++bj) { const f32x4 v0 = acc[ai][bj][m][0], v1 = acc[ai][bj][m][1];
                    u32x4 w; w.x = cvt_pk_bf16(v0[0], v0[1]); w.y = cvt_pk_bf16(v0[2], v0[3]); w.z = cvt_pk_bf16(v1[0], v1[1]); w.w = cvt_pk_bf16(v1[2], v1[3]);
                    *(u32x4*)(rowp + bj * HALF) = w; }
                if (u.pn == misc_pn) { float* pm = PM + (size_t)row * 128 + wc * 32 + 8 * fq; *(f32x4*)pm = acc[ai][0][m][0]; *(f32x4*)(pm + 4) = acc[ai][0][m][1]; } }
    }
};
template <class Epi, class Sched, bool ALIGN_EPI = false, bool SP2 = false>
__device__ __forceinline__ void gemm_phase(PG8_LAS unsigned char* lds, const Gemm g, const Sched& S, const Epi& E) {
    const int tid = threadIdx.x, wid = __builtin_amdgcn_readfirstlane(tid >> 6), lane = tid & 63, wr = wid >> 2, wc = wid & 3, fr = lane & 15, fq = lane >> 4;
    const int K = g.K, nt = K / BK;
    unsigned voffA[2], voffB[2];
#pragma unroll
    for (int i = 0; i < 2; ++i) { int R, C; stage_rc(tid * 16 + i * 8192, R, C); const int Rb = Epi::PERM ? ((R & ~31) + perm32(R & 31)) : R;
        voffA[i] = (unsigned)(R * K + C) * 2u; voffB[i] = (unsigned)(Rb * K + C) * 2u; }
    const size_t kstep = (size_t)(BK * 2);
    const size_t hstep = (size_t)HALF * K * 2;
    const size_t tstep = 2 * hstep;
    const unsigned ldsw = (unsigned)wid * 1024u;
    const int aoff = lds_byte(wr * 64 + fr, fq * 8), boff = lds_byte(wc * 32 + fr, fq * 8);
#define PG8_SA(b, h) (((b) * 2 + (h)) * HTB)
#define PG8_SB(b, h) ((4 + (b) * 2 + (h)) * HTB)
#define PG8_STAGE(bufoff, gbase, voff) do { _Pragma("unroll") for (int _i = 0; _i < 2; ++_i) \
        __builtin_amdgcn_global_load_lds((const unsigned*)((const char*)(gbase) + (voff)[_i]), (PG8_LAS unsigned*)(lds + (bufoff) + ldsw + _i * 8192), 16, 0, 0); } while (0)
#define PG8_LDA(dst, b, h) do { _Pragma("unroll") for (int m = 0; m < 4; ++m) _Pragma("unroll") for (int k = 0; k < 2; ++k) dst[m][k] = *(const PG8_LAS bf16x8*)(lds + PG8_SA(b, h) + aoff + m * 2048 + k * 1024); } while (0)
#define PG8_LDB(dst, b, h) do { _Pragma("unroll") for (int n = 0; n < 2; ++n) _Pragma("unroll") for (int k = 0; k < 2; ++k) dst[n][k] = *(const PG8_LAS bf16x8*)(lds + PG8_SB(b, h) + boff + n * 2048 + k * 1024); } while (0)
#define PG8_MMA(ai, bj, At, Bt) do { __builtin_amdgcn_s_setprio(1); _Pragma("unroll") for (int m = 0; m < 4; ++m) _Pragma("unroll") for (int n = 0; n < 2; ++n) _Pragma("unroll") for (int k = 0; k < 2; ++k) \
        acc[ai][bj][m][n] = __builtin_amdgcn_mfma_f32_16x16x32_bf16(Bt[n][k], At[m][k], acc[ai][bj][m][n], 0, 0, 0); __builtin_amdgcn_s_setprio(0); } while (0)
#define PG8_WAIT_V(n) asm volatile("s_waitcnt vmcnt(" #n ")" ::: "memory")
#define PG8_WAIT_L(n) asm volatile("s_waitcnt lgkmcnt(" #n ")" ::: "memory")
#define PG8_BAR __builtin_amdgcn_s_barrier()
#define PG8_SCHED __builtin_amdgcn_sched_barrier(0)
    Unit cur, nxt; int ui = 0;
    if (!S.next(0, cur)) return;
    f32x4 acc[2][2][4][2];
#pragma unroll
    for (int a = 0; a < 2; ++a)
#pragma unroll
        for (int b = 0; b < 2; ++b)
#pragma unroll
            for (int m = 0; m < 4; ++m)
#pragma unroll
                for (int n = 0; n < 2; ++n) acc[a][b][m][n] = (f32x4){0.f, 0.f, 0.f, 0.f};
    bf16x8 At[4][2], B0[2][2], B1[2][2];
    const char* cA = (const char*)g.A + (size_t)cur.pm * tstep; const char* cB = (const char*)g.Bt + (size_t)cur.pn * tstep;
    S.a_ready(cur);
    if constexpr (SP2) {
        PG8_STAGE(PG8_SB(0, 0), cB, voffB); PG8_STAGE(PG8_SB(0, 1), cB + hstep, voffB); PG8_STAGE(PG8_SA(0, 0), cA, voffA); PG8_STAGE(PG8_SA(0, 1), cA + hstep, voffA);
        if (wr == 1) PG8_BAR;
        PG8_WAIT_V(2); PG8_BAR;
        PG8_STAGE(PG8_SB(1, 0), cB + kstep, voffB); PG8_STAGE(PG8_SA(1, 0), cA + kstep, voffA); PG8_STAGE(PG8_SB(1, 1), cB + hstep + kstep, voffB);
        PG8_WAIT_V(6); PG8_BAR;
    } else {
        PG8_STAGE(PG8_SB(0, 0), cB, voffB); PG8_STAGE(PG8_SA(0, 0), cA, voffA); PG8_STAGE(PG8_SB(0, 1), cB + hstep, voffB); PG8_STAGE(PG8_SA(0, 1), cA + hstep, voffA);
        if (wr == 1) PG8_BAR;
        PG8_WAIT_V(4); PG8_BAR;
        PG8_STAGE(PG8_SB(1, 0), cB + kstep, voffB); PG8_STAGE(PG8_SA(1, 0), cA + kstep, voffA); PG8_STAGE(PG8_SB(1, 1), cB + hstep + kstep, voffB);
        PG8_WAIT_V(6); PG8_BAR;
    }
    for (;;) {
        const bool has_next = S.next(ui + 1, nxt);
        const char* nA = has_next ? (const char*)g.A + (size_t)nxt.pm * tstep : cA; const char* nB = has_next ? (const char*)g.Bt + (size_t)nxt.pn * tstep : cB;
        for (int t = 0; t < nt; t += 2) {
            const bool last = (t == nt - 2);
            const char* a1 = cA + (size_t)(t + 1) * kstep;
            const char* a2 = last ? nA : cA + (size_t)(t + 2) * kstep; const char* b2 = last ? nB : cB + (size_t)(t + 2) * kstep;
            const char* a3 = a2 + kstep; const char* b3 = b2 + kstep;
            if (last && has_next) S.a_ready(nxt);
            if constexpr (SP2) {
            PG8_LDB(B0, 0, 0); PG8_LDB(B1, 0, 1); PG8_SCHED; PG8_LDA(At, 0, 0); PG8_STAGE(PG8_SA(1, 1), a1 + hstep, voffA);
            PG8_WAIT_V(8); PG8_WAIT_L(0); PG8_BAR; PG8_MMA(0, 0, At, B0); PG8_MMA(0, 1, At, B1); PG8_BAR; PG8_SCHED;
            PG8_LDA(At, 0, 1); PG8_STAGE(PG8_SB(0, 0), b2, voffB); PG8_STAGE(PG8_SB(0, 1), b2 + hstep, voffB); PG8_STAGE(PG8_SA(0, 0), a2, voffA);
            PG8_WAIT_V(8); PG8_WAIT_L(0); PG8_BAR; PG8_MMA(1, 0, At, B0); PG8_MMA(1, 1, At, B1); PG8_BAR; PG8_SCHED;
            PG8_LDB(B0, 1, 0); PG8_LDB(B1, 1, 1); PG8_SCHED; PG8_LDA(At, 1, 0); PG8_STAGE(PG8_SA(0, 1), a2 + hstep, voffA);
            PG8_WAIT_V(8); PG8_WAIT_L(0); PG8_BAR; PG8_MMA(0, 0, At, B0); PG8_MMA(0, 1, At, B1); PG8_BAR; PG8_SCHED;
            PG8_LDA(At, 1, 1); PG8_STAGE(PG8_SB(1, 0), b3, voffB); PG8_STAGE(PG8_SB(1, 1), b3 + hstep, voffB); PG8_STAGE(PG8_SA(1, 0), a3, voffA);
            PG8_WAIT_V(8); PG8_WAIT_L(0); PG8_BAR; PG8_MMA(1, 0, At, B0); PG8_MMA(1, 1, At, B1); PG8_BAR; PG8_SCHED;
            } else {
            PG8_LDB(B0, 0, 0); PG8_SCHED; PG8_LDA(At, 0, 0); PG8_STAGE(PG8_SA(1, 1), a1 + hstep, voffA);
            PG8_WAIT_L(8); PG8_BAR; PG8_WAIT_L(0); PG8_MMA(0, 0, At, B0); PG8_BAR; PG8_SCHED;
            PG8_LDB(B1, 0, 1); PG8_STAGE(PG8_SB(0, 0), b2, voffB);
            PG8_BAR; PG8_WAIT_L(0); PG8_MMA(0, 1, At, B1); PG8_BAR;
            PG8_LDA(At, 0, 1); PG8_STAGE(PG8_SA(0, 0), a2, voffA);
            PG8_BAR; PG8_WAIT_L(0); PG8_MMA(1, 0, At, B0); PG8_BAR; PG8_SCHED;
            PG8_STAGE(PG8_SB(0, 1), b2 + hstep, voffB);
            PG8_WAIT_V(6); PG8_BAR; PG8_MMA(1, 1, At, B1); PG8_BAR;
            PG8_LDB(B0, 1, 0); PG8_SCHED; PG8_LDA(At, 1, 0); PG8_STAGE(PG8_SA(0, 1), a2 + hstep, voffA);
            PG8_WAIT_L(8); PG8_BAR; PG8_WAIT_L(0); PG8_MMA(0, 0, At, B0); PG8_BAR; PG8_SCHED;
            PG8_LDB(B1, 1, 1); PG8_STAGE(PG8_SB(1, 0), b3, voffB);
            PG8_BAR; PG8_WAIT_L(0); PG8_MMA(0, 1, At, B1); PG8_BAR;
            PG8_LDA(At, 1, 1); PG8_STAGE(PG8_SA(1, 0), a3, voffA);
            PG8_BAR; PG8_WAIT_L(0); PG8_MMA(1, 0, At, B0); PG8_BAR; PG8_SCHED;
            PG8_STAGE(PG8_SB(1, 1), b3 + hstep, voffB);
            PG8_WAIT_V(6); PG8_BAR; PG8_MMA(1, 1, At, B1); PG8_BAR;
            }
        }
        if constexpr (ALIGN_EPI) { if (wr == 0) PG8_BAR; }
        if constexpr (!Epi::AFTER_DRAIN) { E(acc, cur, wr, wc, fr, fq); S.done(cur); }
        if (!has_next) break;
#pragma unroll
        for (int a = 0; a < 2; ++a)
#pragma unroll
            for (int b = 0; b < 2; ++b)
#pragma unroll
                for (int m = 0; m < 4; ++m)
#pragma unroll
                    for (int n = 0; n < 2; ++n) acc[a][b][m][n] = (f32x4){0.f, 0.f, 0.f, 0.f};
        cur = nxt; cA = nA; cB = nB; ++ui;
        if constexpr (ALIGN_EPI) { if (wr == 1) PG8_BAR; }
    }
    PG8_WAIT_V(0);
    if constexpr (!ALIGN_EPI) { if (wr == 0) PG8_BAR; }
    PG8_BAR;
    if constexpr (Epi::AFTER_DRAIN) { E.fused(acc, cur, wr, wc, fr, fq, lds, wid, lane); S.done(cur); }
#undef PG8_SA
#undef PG8_SB
#undef PG8_STAGE
#undef PG8_LDA
#undef PG8_LDB
#undef PG8_MMA
#undef PG8_WAIT_V
#undef PG8_WAIT_L
#undef PG8_BAR
#undef PG8_SCHED
}
}
constexpr int NB = 8, T = 4096, D = 1024, M = NB * T, FF = 2816, NIN = 3840, IN_TOTAL = 3672;
constexpr int PC_GQ = 0, PC_GK = 256, PC_GV = 512, PC_GG = 1024, PC_DQ = 1536, PC_DK = 2048, PC_DV = 2560, PC_IQ = 3072, PC_IK = 3584, PC_GA = 3648, PC_IW = 3664;
constexpr float LN_EPS = 1e-5f, RMS_EPS = 1e-6f;
constexpr float ALPHA = 1.189207115002721f;
constexpr size_t MiB = 1u << 20;
constexpr size_t WS_W1GU = 2 * MiB, WS_W1D = 13 * MiB, WS_WIN = 19 * MiB, WS_WOUT = 27 * MiB, WS_W2GU = 29 * MiB, WS_W2D = 40 * MiB;
constexpr size_t WS_XB = 50 * MiB, WS_H = 114 * MiB, WS_Y = 290 * MiB, WS_P = 114 * MiB, WS_U = 354 * MiB, WS_O = 418 * MiB, WS_PM = 482 * MiB, WS_G = 498 * MiB, WS_END = 499 * MiB;
constexpr int LDS_BYTES = 147456;
constexpr int NTHREADS = 512;

#define LAS __attribute__((address_space(3)))
typedef unsigned short bf16;
typedef float f32x4 __attribute__((ext_vector_type(4)));
typedef float f32x16 __attribute__((ext_vector_type(16)));
typedef short bf16x8 __attribute__((ext_vector_type(8)));
typedef unsigned u32x4 __attribute__((ext_vector_type(4)));
typedef unsigned u32x2 __attribute__((ext_vector_type(2)));

__device__ __forceinline__ unsigned f2bf(float f) { unsigned u = __builtin_bit_cast(unsigned, f); return (u + 0x7fffu + ((u >> 16) & 1u)) >> 16; }
__device__ __forceinline__ unsigned pk2(float lo, float hi) { return f2bf(lo) | (f2bf(hi) << 16); }
__device__ __forceinline__ float bf2f(unsigned short b) { return __builtin_bit_cast(float, (unsigned)b << 16); }
__device__ __forceinline__ float bflo(unsigned w) { return __builtin_bit_cast(float, w << 16); }
__device__ __forceinline__ float bfhi(unsigned w) { return __builtin_bit_cast(float, w & 0xffff0000u); }
__device__ __forceinline__ float silu(float g) { return g * __builtin_amdgcn_rcpf(1.0f + __expf(-g)); }
__device__ __forceinline__ float wave_sum(float v) {
#pragma unroll
    for (int o = 1; o < 64; o <<= 1) v += __shfl_xor(v, o);
    return v;
}
#define MFMA32(a, b, c) __builtin_amdgcn_mfma_f32_32x32x16_bf16((a), (b), (c), 0, 0, 0)
__device__ __forceinline__ int perm64(int k) { return (k & 32) | (k & 16) | (((k >> 2) & 1) << 3) | (((k >> 3) & 1) << 2) | (k & 3); }

struct MapId { __device__ __forceinline__ int operator()(int n) const { return n; } };
struct MapGU { __device__ __forceinline__ int operator()(int n) const { const int pn = n >> 8, bj = (n >> 7) & 1, j = n & 127; return bj * FF + pn * 128 + j; } };
struct MapIn { __device__ __forceinline__ int operator()(int n) const {
    if (n < 1536) return n;
    if (n < 3584) return n + 16;
    if (n < 3648) return 3600 + (n - 3584);
    if (n < 3664) return 1536 + (n - 3648);
    if (n < 3672) return 3664 + (n - 3664);
    return -1; } };
template <class Map>
__device__ __forceinline__ void transpose_item(const float* W, int K, int N, int ND, bf16* WT, LAS float* scr, int item, int lane, Map map) {
    const int nblk = ND / 32, kb = item / nblk, nb = item % nblk, k0 = 64 * kb, n0 = 32 * nb;
    const int src = map(n0 + (lane & 31));
#pragma unroll 8
    for (int i = 0; i < 32; ++i) { const int kk = 2 * i + (lane >> 5); scr[kk * 33 + (lane & 31)] = src >= 0 ? W[(size_t)(k0 + kk) * N + src] : 0.f; }
    asm volatile("s_waitcnt lgkmcnt(0)" ::: "memory");
    const int c = lane & 7;
#pragma unroll
    for (int j = 0; j < 4; ++j) { const int n = (lane >> 3) + 8 * j; const LAS float* s = scr + (8 * c) * 33 + n;
        u32x4 o; o.x = pk2(s[0 * 33], s[1 * 33]); o.y = pk2(s[2 * 33], s[3 * 33]); o.z = pk2(s[4 * 33], s[5 * 33]); o.w = pk2(s[6 * 33], s[7 * 33]);
        *(u32x4*)(WT + (size_t)(n0 + n) * K + k0 + 8 * c) = o; }
    asm volatile("s_waitcnt lgkmcnt(0)" ::: "memory");
}

__device__ __forceinline__ void ln_rows(const float* Y, const float* g, const float* be, float* Xf, bf16* Xb, int gw, int NGW, int lane) {
    f32x4 gv[4], bv[4];
#pragma unroll
    for (int j = 0; j < 4; ++j) { gv[j] = ((const f32x4*)g)[64 * j + lane]; bv[j] = ((const f32x4*)be)[64 * j + lane]; }
    for (int m = gw; m < M; m += NGW) {
        const f32x4* xr = (const f32x4*)(Y + (size_t)m * D) + lane;
        f32x4 v[4]; float s = 0.f;
#pragma unroll
        for (int j = 0; j < 4; ++j) { v[j] = xr[64 * j]; s += (v[j].x + v[j].y) + (v[j].z + v[j].w); }
        const float mean = wave_sum(s) * (1.f / D); float s2 = 0.f;
#pragma unroll
        for (int j = 0; j < 4; ++j) { v[j] = v[j] - mean; s2 += (v[j].x * v[j].x + v[j].y * v[j].y) + (v[j].z * v[j].z + v[j].w * v[j].w); }
        const float rstd = 1.f / sqrtf(wave_sum(s2) * (1.f / D) + LN_EPS);
#pragma unroll
        for (int j = 0; j < 4; ++j) { const f32x4 o = v[j] * rstd * gv[j] + bv[j];
            if (Xf) ((f32x4*)(Xf + (size_t)m * D))[64 * j + lane] = o;
            if (Xb) { u32x2 w; w.x = pk2(o.x, o.y); w.y = pk2(o.z, o.w); ((u32x2*)(Xb + (size_t)m * D))[64 * j + lane] = w; } }
    }
}

constexpr int GL_BL = 0, GL_SEGT = 16640, GL_QS = 18688, GL_KS = GL_QS + 9216, GL_VT = GL_KS + 9216, GL_ST = GL_VT + 18432, GL_RED = GL_ST + 18432, GL_END = GL_RED + 1024;
__device__ __forceinline__ void gla_b(LAS unsigned char* lds, const float* PM, const float* w2, const float* ba, int row0, int h, int tid) {
    LAS float* BL = (LAS float*)(lds + GL_BL); LAS float* SEGT = (LAS float*)(lds + GL_SEGT);
    const int d = tid & 63, seg = tid >> 6;
    float wcol[16];
#pragma unroll
    for (int r = 0; r < 16; ++r) wcol[r] = w2[r * 256 + h * 64 + d];
    const float bias = ba[h * 64 + d];
    float pre[8]; float run = 0.f;
#pragma unroll
    for (int t = 0; t < 8; ++t) { const float* ga = PM + (size_t)(row0 + seg * 8 + t) * 128 + 64; float z = bias;
#pragma unroll
        for (int r = 0; r < 16; ++r) z += ga[r] * wcol[r];
        const float ls = fminf(z, 0.f) - __logf(1.0f + __expf(-fabsf(z)));
        run += ls * (1.f / 16.f); pre[t] = run; }
    SEGT[seg * 64 + d] = run;
    __syncthreads();
    float off = 0.f;
#pragma unroll
    for (int s = 0; s < 8; ++s) off += (s < seg) ? SEGT[s * 64 + d] : 0.f;
#pragma unroll
    for (int t = 0; t < 8; ++t) BL[(seg * 8 + t) * 65 + d] = pre[t] + off;
    __syncthreads();
}
__device__ __forceinline__ void gla_stage_vt(LAS unsigned char* lds, const bf16* P, int row0, int h, int tid) {
    LAS bf16* VT = (LAS bf16*)(lds + GL_VT);
#pragma unroll
    for (int i = 0; i < 2; ++i) { const int piece = tid + i * NTHREADS, j = piece >> 4, c = piece & 15, pj = perm64(j);
        const u32x4 v = *(const u32x4*)(P + (size_t)(row0 + j) * NIN + PC_GV + h * 128 + c * 8);
        VT[(c * 8 + 0) * 72 + pj] = (bf16)(v.x & 0xffff); VT[(c * 8 + 1) * 72 + pj] = (bf16)(v.x >> 16);
        VT[(c * 8 + 2) * 72 + pj] = (bf16)(v.y & 0xffff); VT[(c * 8 + 3) * 72 + pj] = (bf16)(v.y >> 16);
        VT[(c * 8 + 4) * 72 + pj] = (bf16)(v.z & 0xffff); VT[(c * 8 + 5) * 72 + pj] = (bf16)(v.z >> 16);
        VT[(c * 8 + 6) * 72 + pj] = (bf16)(v.w & 0xffff); VT[(c * 8 + 7) * 72 + pj] = (bf16)(v.w >> 16); }
}
__device__ __forceinline__ void gla_g1_item(LAS unsigned char* lds, const bf16* P, const float* PM, const float* w2, const float* ba, float* U, float* G, int item, int tid) {
    const int bh = item >> 6, n = item & 63, b = bh >> 2, h = bh & 3, row0 = b * T + n * 64;
    const int lane = tid & 63, wave = tid >> 6, l32 = lane & 31, hi = lane >> 5;
    gla_b(lds, PM, w2, ba, row0, h, tid);
    LAS float* BL = (LAS float*)(lds + GL_BL); LAS bf16* KHT = (LAS bf16*)(lds + GL_QS); LAS bf16* VT = (LAS bf16*)(lds + GL_VT);
    { const int j = tid >> 3, dg = tid & 7, pj = perm64(j);
      const u32x4 kv = *(const u32x4*)(P + (size_t)(row0 + j) * NIN + PC_GK + h * 64 + dg * 8);
      const unsigned kw[4] = {kv.x, kv.y, kv.z, kv.w};
#pragma unroll
      for (int e = 0; e < 8; ++e) { const int d = dg * 8 + e; const float kf = (e & 1) ? bfhi(kw[e >> 1]) : bflo(kw[e >> 1]);
          KHT[d * 72 + pj] = (bf16)f2bf(kf * __expf(BL[63 * 65 + d] - BL[j * 65 + d])); } }
    gla_stage_vt(lds, P, row0, h, tid);
    __syncthreads();
    { const int dvt = wave & 3, dt = wave >> 2;
      f32x16 acc;
#pragma unroll
      for (int r = 0; r < 16; ++r) acc[r] = 0.f;
#pragma unroll
      for (int s = 0; s < 4; ++s) { const bf16x8 a = *(const LAS bf16x8*)(VT + (dvt * 32 + l32) * 72 + s * 16 + hi * 8); const bf16x8 bb = *(const LAS bf16x8*)(KHT + (dt * 32 + l32) * 72 + s * 16 + hi * 8);
          acc = MFMA32(a, bb, acc); }
#pragma unroll
      for (int r = 0; r < 16; ++r) { const int dv = dvt * 32 + 8 * (r >> 2) + 4 * hi + (r & 3); U[((size_t)item * 128 + dv) * 64 + dt * 32 + l32] = acc[r]; } }
    if (tid < 64) G[item * 64 + tid] = __expf(BL[63 * 65 + tid]);
    __syncthreads();
}
__device__ __forceinline__ void gla_g3_item(LAS unsigned char* lds, const bf16* P, const float* PM, const float* w2, const float* ba, const float* gnorm, const float* U, bf16* O, int item, int tid) {
    const int bh = item >> 6, n = item & 63, b = bh >> 2, h = bh & 3, row0 = b * T + n * 64;
    const int lane = tid & 63, wave = tid >> 6, l32 = lane & 31, hi = lane >> 5;
    gla_b(lds, PM, w2, ba, row0, h, tid);
    LAS float* BL = (LAS float*)(lds + GL_BL); LAS bf16* QS = (LAS bf16*)(lds + GL_QS); LAS bf16* KS = (LAS bf16*)(lds + GL_KS);
    LAS bf16* VT = (LAS bf16*)(lds + GL_VT); LAS bf16* ST = (LAS bf16*)(lds + GL_ST); LAS float* RED = (LAS float*)(lds + GL_RED);
    { const int i = tid >> 3, dg = tid & 7;
      const u32x4 qv = *(const u32x4*)(P + (size_t)(row0 + i) * NIN + PC_GQ + h * 64 + dg * 8);
      const u32x4 kv = *(const u32x4*)(P + (size_t)(row0 + i) * NIN + PC_GK + h * 64 + dg * 8);
      const unsigned qw[4] = {qv.x, qv.y, qv.z, qv.w}, kw[4] = {kv.x, kv.y, kv.z, kv.w};
      unsigned qo[4], ko[4];
#pragma unroll
      for (int e2 = 0; e2 < 4; ++e2) { const float b0 = BL[i * 65 + dg * 8 + 2 * e2], b1 = BL[i * 65 + dg * 8 + 2 * e2 + 1];
          qo[e2] = pk2(bflo(qw[e2]) * __expf(b0) * 0.125f, bfhi(qw[e2]) * __expf(b1) * 0.125f);
          ko[e2] = pk2(bflo(kw[e2]) * __expf(-b0), bfhi(kw[e2]) * __expf(-b1)); }
      *(LAS u32x4*)(QS + i * 72 + dg * 8) = (u32x4){qo[0], qo[1], qo[2], qo[3]};
      *(LAS u32x4*)(KS + i * 72 + dg * 8) = (u32x4){ko[0], ko[1], ko[2], ko[3]}; }
    gla_stage_vt(lds, P, row0, h, tid);
#pragma unroll
    for (int i = 0; i < 4; ++i) { const int idx4 = tid + i * NTHREADS, dv = idx4 >> 4, d4 = (idx4 & 15) * 4;
        const f32x4 s = *(const f32x4*)(U + ((size_t)item * 128 + dv) * 64 + d4);
        *(LAS u32x2*)(ST + dv * 72 + d4) = (u32x2){pk2(s.x, s.y), pk2(s.z, s.w)}; }
    __syncthreads();
    const int dvt = wave & 3, it = wave >> 2;
    f32x16 o;
    {
      bf16x8 qfr[4];
#pragma unroll
      for (int s = 0; s < 4; ++s) qfr[s] = *(const LAS bf16x8*)(QS + (it * 32 + l32) * 72 + s * 16 + hi * 8);
      bf16x8 pf[2][2];
#pragma unroll
      for (int jt = 0; jt < 2; ++jt) { f32x16 a;
#pragma unroll
          for (int r = 0; r < 16; ++r) a[r] = 0.f;
#pragma unroll
          for (int s = 0; s < 4; ++s) { const bf16x8 kf = *(const LAS bf16x8*)(KS + (jt * 32 + l32) * 72 + s * 16 + hi * 8); a = MFMA32(kf, qfr[s], a); }
          const int i = it * 32 + l32;
#pragma unroll
          for (int r = 0; r < 16; ++r) { const int j = jt * 32 + 8 * (r >> 2) + 4 * hi + (r & 3); a[r] = (j <= i) ? a[r] : 0.f; }
#pragma unroll
          for (int s2 = 0; s2 < 2; ++s2) { u32x4 w; w.x = pk2(a[8 * s2 + 0], a[8 * s2 + 1]); w.y = pk2(a[8 * s2 + 2], a[8 * s2 + 3]); w.z = pk2(a[8 * s2 + 4], a[8 * s2 + 5]); w.w = pk2(a[8 * s2 + 6], a[8 * s2 + 7]);
              pf[jt][s2] = __builtin_bit_cast(bf16x8, w); } }
#pragma unroll
      for (int r = 0; r < 16; ++r) o[r] = 0.f;
#pragma unroll
      for (int jt = 0; jt < 2; ++jt)
#pragma unroll
          for (int s2 = 0; s2 < 2; ++s2) { const bf16x8 vf = *(const LAS bf16x8*)(VT + (dvt * 32 + l32) * 72 + jt * 32 + s2 * 16 + hi * 8); o = MFMA32(vf, pf[jt][s2], o); }
#pragma unroll
      for (int s = 0; s < 4; ++s) { const bf16x8 sf = *(const LAS bf16x8*)(ST + (dvt * 32 + l32) * 72 + s * 16 + hi * 8); o = MFMA32(sf, qfr[s], o); }
    }
    float ss = 0.f;
#pragma unroll
    for (int r = 0; r < 16; ++r) ss += o[r] * o[r];
    ss += __shfl_xor(ss, 32);
    if (hi == 0) RED[dvt * 64 + it * 32 + l32] = ss;
    __syncthreads();
    { const int i = it * 32 + l32; const float tot = RED[i] + RED[64 + i] + RED[128 + i] + RED[192 + i];
      const float rs = 1.0f / sqrtf(tot * (1.f / 128.f) + RMS_EPS);
#pragma unroll
      for (int g = 0; g < 4; ++g) { const int dv0 = dvt * 32 + 8 * g + 4 * hi;
          const u32x2 gg = *(const u32x2*)(P + (size_t)(row0 + i) * NIN + PC_GG + h * 128 + dv0);
          const f32x4 gn = *(const f32x4*)(gnorm + dv0);
          const float o0 = o[4 * g + 0] * rs * gn.x * silu(bflo(gg.x)), o1 = o[4 * g + 1] * rs * gn.y * silu(bfhi(gg.x));
          const float o2 = o[4 * g + 2] * rs * gn.z * silu(bflo(gg.y)), o3 = o[4 * g + 3] * rs * gn.w * silu(bfhi(gg.y));
          *(u32x2*)(O + (size_t)(row0 + i) * D + h * 128 + dv0) = (u32x2){pk2(o0, o1), pk2(o2, o3)}; } }
    __syncthreads();
}
__device__ __forceinline__ void vt_item(LAS unsigned char* lds, bf16* P, int item, int tid) {
    const int row0 = item * 64;
    LAS bf16* LV = (LAS bf16*)lds;
#pragma unroll
    for (int i = 0; i < 8; ++i) { const int piece = tid + i * NTHREADS, key = piece >> 6, c16 = piece & 63;
        *(LAS u32x4*)(LV + key * 520 + c16 * 8) = *(const u32x4*)(P + (size_t)(row0 + key) * NIN + PC_DV + c16 * 8); }
    __syncthreads();
    const int col = tid; bf16* dst = P + (size_t)(row0 + (col >> 3)) * NIN + PC_DV + (col & 7) * 64;
#pragma unroll
    for (int pg = 0; pg < 8; ++pg) { unsigned e[8];
#pragma unroll
        for (int jj = 0; jj < 8; ++jj) { const int pos = pg * 8 + jj; const int key = (pos & 32) + (pos & 16) + 8 * (jj >> 2) + 4 * ((pos >> 3) & 1) + (jj & 3); e[jj] = LV[key * 520 + col]; }
        *(u32x4*)(dst + pg * 8) = (u32x4){e[0] | (e[1] << 16), e[2] | (e[3] << 16), e[4] | (e[5] << 16), e[6] | (e[7] << 16)}; }
    __syncthreads();
}

__device__ __forceinline__ unsigned okey(float x) { unsigned bits = __builtin_bit_cast(unsigned, x); if (bits == 0x80000000u) bits = 0u; return bits ^ ((unsigned)((int)bits >> 31) | 0x80000000u); }
__device__ __forceinline__ void dsa_item(LAS unsigned char* lds, const bf16* P, const float* PM, bf16* O, float* scr, int b, int c, int tid) {
    LAS unsigned* BMK = (LAS unsigned*)lds;
    const int lane = tid & 63, wave = __builtin_amdgcn_readfirstlane(tid >> 6), l32 = lane & 31, hi = lane >> 5;
    const int row0 = b * T + c * 64, nk64 = c + 1;
    const bf16* Kb = P + (size_t)(b * T) * NIN;
    for (int rt = 0; rt < 2; ++rt) {
        const int qbase = row0 + wave * 8 + rt * 4;
        {
            bf16x8 qf[4];
            { const int hh = l32 >> 2, q = l32 & 3; const bf16* qp = P + (size_t)(qbase + q) * NIN + PC_IQ + hh * 64 + hi * 8;
#pragma unroll
              for (int s = 0; s < 4; ++s) qf[s] = *(const bf16x8*)(qp + s * 16); }
            float w[4][4];
#pragma unroll
            for (int q = 0; q < 4; ++q)
#pragma unroll
                for (int g = 0; g < 4; ++g) w[q][g] = PM[(size_t)(qbase + q) * 128 + 80 + 2 * g + hi] * (0.125f * 0.35355339059327373f);
            for (int kt = 0; kt < 2 * nk64; ++kt) {
                const bf16* kp = Kb + (size_t)(kt * 32 + l32) * NIN + PC_IK + hi * 8;
                bf16x8 kf[4];
#pragma unroll
                for (int s = 0; s < 4; ++s) kf[s] = *(const bf16x8*)(kp + s * 16);
                f32x16 acc;
#pragma unroll
                for (int r = 0; r < 16; ++r) acc[r] = 0.f;
#pragma unroll
                for (int s = 0; s < 4; ++s) acc = MFMA32(qf[s], kf[s], acc);
                float part[4];
#pragma unroll
                for (int q = 0; q < 4; ++q) { float p = 0.f;
#pragma unroll
                    for (int g = 0; g < 4; ++g) p += w[q][g] * fmaxf(acc[4 * g + q], 0.f);
                    part[q] = p + __shfl_xor(p, 32); }
                const float a0 = hi ? part[2] : part[0], a1 = hi ? part[3] : part[1];
                scr[(2 * hi) * 4096 + kt * 32 + l32] = a0; scr[(2 * hi + 1) * 4096 + kt * 32 + l32] = a1;
            }
        }
        __builtin_amdgcn_fence(__ATOMIC_RELEASE, "workgroup"); asm volatile("s_waitcnt vmcnt(0)" ::: "memory");
        __builtin_amdgcn_fence(__ATOMIC_ACQUIRE, "workgroup");
        for (int q = 0; q < 4; ++q) {
            LAS unsigned* bmrow = BMK + (wave * 8 + rt * 4 + q) * 129;
            if (c < 4) {
                for (int j = 0; j <= c; ++j) if (lane < 2) bmrow[2 * j + lane] = 0xffffffffu;
            } else {
                unsigned u[64];
#pragma unroll
                for (int g = 0; g < 4; ++g) {
                    if (g * 16 <= c) {
#pragma unroll
                        for (int jj = 0; jj < 16; ++jj) { const int j = g * 16 + jj; const float x = scr[q * 4096 + j * 64 + lane]; u[j] = (j <= c) ? okey(x) : 0u; }
                    } else {
#pragma unroll
                        for (int jj = 0; jj < 16; ++jj) u[g * 16 + jj] = 0u;
                    }
                }
                unsigned cur = 0u;
                for (int bit = 31; bit >= 0; --bit) {
                    const unsigned cand = cur | (1u << bit); int cnt = 0;
#pragma unroll
                    for (int g = 0; g < 4; ++g) if (g * 16 <= c) {
#pragma unroll
                        for (int jj = 0; jj < 16; ++jj) cnt += __popcll(__ballot(u[g * 16 + jj] >= cand));
                    }
                    if (cnt >= 256) cur = cand;
                }
                int cgt = 0;
#pragma unroll
                for (int g = 0; g < 4; ++g) if (g * 16 <= c) {
#pragma unroll
                    for (int jj = 0; jj < 16; ++jj) cgt += __popcll(__ballot(u[g * 16 + jj] > cur));
                }
                int need = 256 - cgt;
#pragma unroll
                for (int g = 0; g < 4; ++g) if (g * 16 <= c) {
#pragma unroll
                    for (int jj = 0; jj < 16; ++jj) { const int j = g * 16 + jj;
                        const unsigned long long gt = __ballot(u[j] > cur); unsigned long long eq = __ballot(u[j] == cur);
                        int ne = __popcll(eq);
                        while (ne > need) { eq &= ~(1ull << (63 - __clzll((long long)eq))); --ne; }
                        need -= ne;
                        const unsigned long long mm = gt | eq;
                        if (lane < 2) bmrow[2 * j + lane] = lane ? (unsigned)(mm >> 32) : (unsigned)mm; }
                }
            }
        }
    }
    __syncthreads();
    {
        const int h = wave;
        bf16x8 qf[2][4];
#pragma unroll
        for (int qt = 0; qt < 2; ++qt)
#pragma unroll
            for (int s = 0; s < 4; ++s) qf[qt][s] = *(const bf16x8*)(P + (size_t)(row0 + qt * 32 + l32) * NIN + PC_DQ + h * 64 + s * 16 + hi * 8);
        f32x16 oacc[2][2];
#pragma unroll
        for (int a = 0; a < 2; ++a)
#pragma unroll
            for (int bq = 0; bq < 2; ++bq)
#pragma unroll
                for (int r = 0; r < 16; ++r) oacc[a][bq][r] = 0.f;
        float lsum[2] = {0.f, 0.f};
        const float cs = 0.125f * 1.4426950408889634f;
        for (int kt = 0; kt < 2 * nk64; ++kt) {
            const bf16* kp = Kb + (size_t)(kt * 32 + l32) * NIN + PC_DK + h * 64 + hi * 8;
            bf16x8 kf[4];
#pragma unroll
            for (int s = 0; s < 4; ++s) kf[s] = *(const bf16x8*)(kp + s * 16);
            bf16x8 vf[2][2];
#pragma unroll
            for (int dt = 0; dt < 2; ++dt) { const int col = h * 64 + dt * 32 + l32;
                const bf16* vp = Kb + (size_t)((kt >> 1) * 64 + (col >> 3)) * NIN + PC_DV + (col & 7) * 64 + (kt & 1) * 32 + hi * 8;
                vf[dt][0] = *(const bf16x8*)vp; vf[dt][1] = *(const bf16x8*)(vp + 16); }
#pragma unroll
            for (int qt = 0; qt < 2; ++qt) {
                f32x16 S;
#pragma unroll
                for (int r = 0; r < 16; ++r) S[r] = 0.f;
#pragma unroll
                for (int s = 0; s < 4; ++s) S = MFMA32(kf[s], qf[qt][s], S);
                const unsigned wsh = BMK[(qt * 32 + l32) * 129 + kt] >> (4 * hi);
                float p[16]; float ls = 0.f;
#pragma unroll
                for (int r = 0; r < 16; ++r) { const int bp = 8 * (r >> 2) + (r & 3); p[r] = ((wsh >> bp) & 1u) ? __builtin_amdgcn_exp2f(fminf(S[r] * cs, 100.f)) : 0.f; ls += p[r]; }
                lsum[qt] += ls;
                bf16x8 pf[2];
#pragma unroll
                for (int s2 = 0; s2 < 2; ++s2) { u32x4 wv; wv.x = pk2(p[8 * s2 + 0], p[8 * s2 + 1]); wv.y = pk2(p[8 * s2 + 2], p[8 * s2 + 3]); wv.z = pk2(p[8 * s2 + 4], p[8 * s2 + 5]); wv.w = pk2(p[8 * s2 + 6], p[8 * s2 + 7]);
                    pf[s2] = __builtin_bit_cast(bf16x8, wv); }
#pragma unroll
                for (int dt = 0; dt < 2; ++dt)
#pragma unroll
                    for (int s2 = 0; s2 < 2; ++s2) oacc[dt][qt] = MFMA32(vf[dt][s2], pf[s2], oacc[dt][qt]);
            }
        }
#pragma unroll
        for (int qt = 0; qt < 2; ++qt) { const float tot = lsum[qt] + __shfl_xor(lsum[qt], 32); const float inv = 1.0f / tot;
            bf16* orow = O + (size_t)(row0 + qt * 32 + l32) * D + 512 + h * 64;
#pragma unroll
            for (int dt = 0; dt < 2; ++dt)
#pragma unroll
                for (int g = 0; g < 4; ++g) { const int d0 = dt * 32 + 8 * g + 4 * hi;
                    *(u32x2*)(orow + d0) = (u32x2){pk2(oacc[dt][qt][4 * g] * inv, oacc[dt][qt][4 * g + 1] * inv), pk2(oacc[dt][qt][4 * g + 2] * inv, oacc[dt][qt][4 * g + 3] * inv)}; } }
    }
    __syncthreads();
}

struct Args { const float* in[16]; float* out; unsigned char* ws; };
__global__ void __launch_bounds__(NTHREADS, 2) hymba_fwd(Args args) {
    extern __shared__ __attribute__((aligned(16))) unsigned char lds_raw[];
    LAS unsigned char* lds = (LAS unsigned char*)lds_raw;
    cg::grid_group grid = cg::this_grid();
    const int tid = threadIdx.x, lane = tid & 63, wave = __builtin_amdgcn_readfirstlane(tid >> 6);
    const int G = gridDim.x, bx = blockIdx.x;
    const int gw = bx * 8 + wave, NGW = G * 8;
    unsigned char* ws = args.ws;
    const float* x = args.in[0]; const float* w_in = args.in[1]; const float* w_a2 = args.in[2]; const float* b_a = args.in[3]; const float* gnorm = args.in[4]; const float* w_out = args.in[5];
    const float* f1gu = args.in[6]; const float* f1d = args.in[7]; const float* f2gu = args.in[8]; const float* f2d = args.in[9];
    const float *ln1g = args.in[10], *ln1b = args.in[11], *ln2g = args.in[12], *ln2b = args.in[13], *ln3g = args.in[14], *ln3b = args.in[15];
    bf16 *W1GU = (bf16*)(ws + WS_W1GU), *W1D = (bf16*)(ws + WS_W1D), *WIN = (bf16*)(ws + WS_WIN), *WOUT = (bf16*)(ws + WS_WOUT), *W2GU = (bf16*)(ws + WS_W2GU), *W2D = (bf16*)(ws + WS_W2D);
    bf16 *XB = (bf16*)(ws + WS_XB), *HB = (bf16*)(ws + WS_H), *PB = (bf16*)(ws + WS_P), *OB = (bf16*)(ws + WS_O);
    float *Y = (float*)(ws + WS_Y), *U = (float*)(ws + WS_U), *PM = (float*)(ws + WS_PM), *GD = (float*)(ws + WS_G);
    float* XF = args.out;

    {
        LAS float* scr = (LAS float*)(lds + wave * 16384);
        constexpr int I_GU = (D / 64) * (2 * FF / 32), I_D = (FF / 64) * (D / 32), I_IN = (D / 64) * (NIN / 32), I_OUT = (D / 64) * (D / 32);
        constexpr int NITEMS = 2 * I_GU + 2 * I_D + I_IN + I_OUT;
        for (int it = gw; it < NITEMS; it += NGW) {
            int r = it;
            if (r < I_GU) { transpose_item(f1gu, D, 2 * FF, 2 * FF, W1GU, scr, r, lane, MapGU()); continue; } r -= I_GU;
            if (r < I_GU) { transpose_item(f2gu, D, 2 * FF, 2 * FF, W2GU, scr, r, lane, MapGU()); continue; } r -= I_GU;
            if (r < I_D) { transpose_item(f1d, FF, D, D, W1D, scr, r, lane, MapId()); continue; } r -= I_D;
            if (r < I_D) { transpose_item(f2d, FF, D, D, W2D, scr, r, lane, MapId()); continue; } r -= I_D;
            if (r < I_IN) { transpose_item(w_in, D, IN_TOTAL, NIN, WIN, scr, r, lane, MapIn()); continue; } r -= I_IN;
            transpose_item(w_out, D, D, D, WOUT, scr, r, lane, MapId());
        }
        const size_t n8 = (size_t)M * D / 8;
        for (size_t i = (size_t)bx * NTHREADS + tid; i < n8; i += (size_t)G * NTHREADS) {
            const f32x4 a = ((const f32x4*)x)[2 * i], c = ((const f32x4*)x)[2 * i + 1];
            ((u32x4*)XB)[i] = (u32x4){pk2(a.x, a.y), pk2(a.z, a.w), pk2(c.x, c.y), pk2(c.z, c.w)};
        }
    }
    grid.sync();
    { pg8::Gemm g{XB, W1GU, M, 2 * FF, D}; pg8::StaticOrder S; S.init(M, 2 * FF, G, bx); pg8::EpiSwiglu E{HB, FF};
      pg8::gemm_phase<pg8::EpiSwiglu, pg8::StaticOrder, true, true>(lds, g, S, E); }
    grid.sync();
    { pg8::Gemm g{HB, W1D, M, D, FF}; pg8::StaticOrder S; S.init(M, D, G, bx); pg8::EpiResF32 E{x, Y, D, ALPHA, 0.5f};
      pg8::gemm_phase<pg8::EpiResF32, pg8::StaticOrder, true, true>(lds, g, S, E); }
    grid.sync();
    ln_rows(Y, ln1g, ln1b, XF, XB, gw, NGW, lane);
    grid.sync();
    { pg8::Gemm g{XB, WIN, M, NIN, D}; pg8::StaticOrder S; S.init(M, NIN, G, bx); pg8::EpiProj E{PB, NIN, PM, NIN / 256 - 1};
      pg8::gemm_phase<pg8::EpiProj, pg8::StaticOrder, true, true>(lds, g, S, E); }
    grid.sync();
    for (int it = bx; it < NB * 4 * 64; it += G) gla_g1_item(lds, PB, PM, w_a2, b_a, U, GD, it, tid);
    for (int it = bx; it < NB * 64; it += G) vt_item(lds, PB, it, tid);
    grid.sync();
    { const int gt = bx * NTHREADS + tid;
      if (gt < NB * 4 * 4096) { const int bh = gt >> 12, e2 = (gt & 4095) * 2, d = e2 & 63; float s0 = 0.f, s1 = 0.f;
#pragma unroll 4
          for (int n = 0; n < 64; ++n) { const int item = bh * 64 + n; float* up = U + (size_t)item * 8192 + e2;
              const float u0 = up[0], u1 = up[1], g0 = GD[item * 64 + d], g1 = GD[item * 64 + d + 1];
              up[0] = s0; up[1] = s1; s0 = g0 * s0 + u0; s1 = g1 * s1 + u1; } } }
    grid.sync();
    for (int it = bx; it < NB * 4 * 64; it += G) gla_g3_item(lds, PB, PM, w_a2, b_a, gnorm, U, OB, it, tid);
    grid.sync();
    { float* scr = (float*)(ws + (bx < 128 ? WS_XB : WS_U)) + ((size_t)(bx & 127) * 8 + wave) * 16384;
      for (int pi = bx; pi < NB * 32; pi += G) { const int b = pi >> 5, c1 = pi & 31;
          dsa_item(lds, PB, PM, OB, scr, b, 63 - c1, tid);
          dsa_item(lds, PB, PM, OB, scr, b, c1, tid); } }
    grid.sync();
    { pg8::Gemm g{OB, WOUT, M, D, D}; pg8::StaticOrder S; S.init(M, D, G, bx); pg8::EpiResF32 E{XF, Y, D, ALPHA, 1.0f};
      pg8::gemm_phase<pg8::EpiResF32, pg8::StaticOrder, true, true>(lds, g, S, E); }
    grid.sync();
    ln_rows(Y, ln2g, ln2b, XF, XB, gw, NGW, lane);
    grid.sync();
    { pg8::Gemm g{XB, W2GU, M, 2 * FF, D}; pg8::StaticOrder S; S.init(M, 2 * FF, G, bx); pg8::EpiSwiglu E{HB, FF};
      pg8::gemm_phase<pg8::EpiSwiglu, pg8::StaticOrder, true, true>(lds, g, S, E); }
    grid.sync();
    { pg8::Gemm g{HB, W2D, M, D, FF}; pg8::StaticOrder S; S.init(M, D, G, bx); pg8::EpiResF32 E{XF, Y, D, ALPHA, 0.5f};
      pg8::gemm_phase<pg8::EpiResF32, pg8::StaticOrder, true, true>(lds, g, S, E); }
    grid.sync();
    ln_rows(Y, ln3g, ln3b, XF, (bf16*)nullptr, gw, NGW, lane);
}

extern "C" void kernel_launch(void* const* d_in, const int* in_sizes, int n_in, void* d_out, int out_size, void* d_ws, size_t ws_size, hipStream_t stream) {
    static int grid = 0;
    if (grid == 0) {
        if (n_in != 16 || in_sizes[0] != M * D || out_size != M * D || ws_size < WS_END) { fprintf(stderr, "kernel_launch: unexpected shapes (n_in %d, in0 %d, out %d, ws %zu)\n", n_in, n_in > 0 ? in_sizes[0] : -1, out_size, ws_size); grid = -1; return; }
        int dev = 0, cus = 0, per_cu = 0;
        hipGetDevice(&dev); hipDeviceGetAttribute(&cus, hipDeviceAttributeMultiprocessorCount, dev);
        if (hipFuncSetAttribute((const void*)hymba_fwd, hipFuncAttributeMaxDynamicSharedMemorySize, LDS_BYTES) != hipSuccess) { fprintf(stderr, "kernel_launch: hipFuncSetAttribute failed\n"); grid = -1; return; }
        if (hipOccupancyMaxActiveBlocksPerMultiprocessor(&per_cu, (const void*)hymba_fwd, NTHREADS, LDS_BYTES) != hipSuccess || per_cu < 1) { fprintf(stderr, "kernel_launch: occupancy query says %d blocks per CU\n", per_cu); per_cu = 1; }
        (void)hipGetLastError();
        grid = cus;
    }
    if (grid < 0) return;
    Args a{};
    for (int i = 0; i < 16; ++i) a.in[i] = (const float*)d_in[i];
    a.out = (float*)d_out; a.ws = (unsigned char*)d_ws;
    void* kargs[] = {&a};
    hipError_t e = hipLaunchCooperativeKernel((const void*)hymba_fwd, dim3(grid), dim3(NTHREADS), kargs, LDS_BYTES, stream);
    if (e != hipSuccess) fprintf(stderr, "kernel_launch: cooperative launch failed: %s (grid %d)\n", hipGetErrorString(e), grid);
}
```

```cpp
#include <hip/hip_runtime.h>
#include <hip/hip_cooperative_groups.h>
#include <cstdio>
#include <cstdint>
namespace cg = cooperative_groups;
namespace pg8 {
#define PG8_LAS __attribute__((address_space(3)))
typedef unsigned short bf16_t;
typedef short bf16x8 __attribute__((ext_vector_type(8)));
typedef float f32x4 __attribute__((ext_vector_type(4)));
typedef unsigned u32x4 __attribute__((ext_vector_type(4)));
constexpr int BM = 256, BK = 64, HALF = 128, HTB = HALF * BK * 2  , STAGE_BYTES = 8 * HTB, NXCD = 8, WGM = 8;

__host__ __device__ __forceinline__ int lds_byte(int r, int c) { const int st = (r >> 4) * 2 + (c >> 5), rr = r & 15, cc = c & 31, ob = rr * 64 + cc * 2; return st * 1024 + (ob ^ (((ob >> 9) & 1) << 5)); }
__host__ __device__ __forceinline__ void stage_rc(int b, int& R, int& C) { const int st = b / 1024, sb = b % 1024, swz = sb ^ (((sb >> 9) & 1) << 5); R = (st >> 1) * 16 + swz / 64; C = (st & 1) * 32 + (swz % 64) / 2; }
__host__ __device__ __forceinline__ int perm32(int rho) { const int n = rho >> 4, i = rho & 15; return 8 * (i >> 2) + 4 * n + (i & 3); }

struct Unit { int pm, pn; };
struct Gemm { const bf16_t* A; const bf16_t* Bt; int M, N, K; };

struct StaticOrder {
    int nM, nN, nwg, G, c;
    __host__ __device__ void init(int M, int N, int G_, int c_) { nM = M / BM; nN = N / BM; nwg = nM * nN; G = G_; c = c_; }
    __host__ __device__ bool next(int i, Unit& u) const {
        const long L = (long)i * G + c; if (L >= nwg) return false;
        int wgid = (int)L; { const int q = nwg / NXCD, r = nwg % NXCD, xcd = wgid % NXCD, off = wgid / NXCD; wgid = (xcd < r ? xcd * (q + 1) : r * (q + 1) + (xcd - r) * q) + off; }
        const int nig = WGM * nN, gid = wgid / nig, fm = gid * WGM, gsz = (nM - fm) < WGM ? (nM - fm) : WGM;
        u.pm = fm + ((wgid % nig) % gsz); u.pn = (wgid % nig) / gsz; return true;
    }
    __device__ __forceinline__ void a_ready(const Unit&) const {}
    __device__ __forceinline__ void done(const Unit&) const {}
};

__device__ __forceinline__ unsigned cvt_pk_bf16(float lo, float hi) { unsigned r; asm volatile("v_cvt_pk_bf16_f32 %0, %1, %2" : "=v"(r) : "v"(lo), "v"(hi)); return r; }
typedef float f32x2 __attribute__((ext_vector_type(2)));
__device__ __forceinline__ float silu_f(float g) { return g * __builtin_amdgcn_rcpf(1.0f + __expf(-g)); }
struct EpiSwiglu {
    static constexpr bool PERM = true, AFTER_DRAIN = false;
    bf16_t* O; int ldc;
    __device__ __forceinline__ void operator()(const f32x4 (&acc)[2][2][4][2], const Unit& u, int wr, int wc, int fr, int fq) const {
        asm volatile("" : "+v"(fr), "+v"(fq));
        const int row0 = u.pm * BM + wr * 64 + fr, col0 = u.pn * HALF + wc * 32 + 8 * fq;
#pragma unroll
        for (int ai = 0; ai < 2; ++ai)
#pragma unroll
            for (int m = 0; m < 4; ++m) { bf16_t* rowp = O + (size_t)(row0 + ai * HALF + m * 16) * ldc + col0;
                const f32x4 g0 = acc[ai][0][m][0], g1 = acc[ai][0][m][1], u0 = acc[ai][1][m][0], u1 = acc[ai][1][m][1];
                u32x4 w; w.x = cvt_pk_bf16(silu_f(g0[0]) * u0[0], silu_f(g0[1]) * u0[1]); w.y = cvt_pk_bf16(silu_f(g0[2]) * u0[2], silu_f(g0[3]) * u0[3]);
                w.z = cvt_pk_bf16(silu_f(g1[0]) * u1[0], silu_f(g1[1]) * u1[1]); w.w = cvt_pk_bf16(silu_f(g1[2]) * u1[2], silu_f(g1[3]) * u1[3]);
                *(u32x4*)rowp = w; }
    }
};
struct EpiResF32 {
    static constexpr bool PERM = false, AFTER_DRAIN = false;
    const float* R; float* Y; int ldc; float alpha, scale;
    __device__ __forceinline__ void operator()(const f32x4 (&acc)[2][2][4][2], const Unit& u, int wr, int wc, int fr, int fq) const {
        asm volatile("" : "+v"(fr), "+v"(fq));
        const int col0 = u.pn * BM + wc * 32 + 4 * fq;
#pragma unroll
        for (int ai = 0; ai < 2; ++ai)
#pragma unroll
            for (int m = 0; m < 4; ++m) { const size_t off = (size_t)(u.pm * BM + ai * HALF + wr * 64 + m * 16 + fr) * ldc + col0;
#pragma unroll
                for (int bj = 0; bj < 2; ++bj)
#pragma unroll
                    for (int n = 0; n < 2; ++n) { const f32x4 r = *(const f32x4*)(R + off + bj * HALF + n * 16);
                        *(f32x4*)(Y + off + bj * HALF + n * 16) = r * alpha + acc[ai][bj][m][n] * scale; } }
    }
};
struct EpiProj {
    static constexpr bool PERM = true, AFTER_DRAIN = false;
    bf16_t* O; int ldc; float* PM; int misc_pn;
    __device__ __forceinline__ void operator()(const f32x4 (&acc)[2][2][4][2], const Unit& u, int wr, int wc, int fr, int fq) const {
        asm volatile("" : "+v"(fr), "+v"(fq));
        const int row0 = u.pm * BM + wr * 64 + fr, col0 = u.pn * BM + wc * 32 + 8 * fq;
#pragma unroll
        for (int ai = 0; ai < 2; ++ai)
#pragma unroll
            for (int m = 0; m < 4; ++m) { const int row = row0 + ai * HALF + m * 16; bf16_t* rowp = O + (size_t)row * ldc + col0;
#pragma unroll
                for (int bj = 0; bj < 2; ++bj) { const f32x4 v0 = acc[ai][bj][m][0], v1 = acc[ai][bj][m][1];
                    u32x4 w; w.x = cvt_pk_bf16(v0[0], v0[1]); w.y = cvt_pk_bf16(v0[2], v0[3]); w.z = cvt_pk_bf16(v1[0], v1[1]); w.w = cvt_pk_bf16(v1[2], v1[3]);
                    *(u32x4*)(rowp + bj * HALF) = w; }
                if (u.pn == misc_pn) { float* pm = PM + (size_t)row * 128 + wc * 32 + 8 * fq; *(f32x4*)pm = acc[ai][0][m][0]; *(f32x4*)(pm + 4) = acc[ai][0][m][1]; } }
    }
};
template <class Epi, class Sched, bool ALIGN_EPI = false, bool SP2 = false>
__device__ __forceinline__ void gemm_phase(PG8_LAS unsigned char* lds, const Gemm g, const Sched& S, const Epi& E) {
    int tid_l = threadIdx.x; asm volatile("" : "+v"(tid_l)); const int tid = tid_l, wid = __builtin_amdgcn_readfirstlane(tid >> 6), lane = tid & 63, wr = wid >> 2, wc = wid & 3, fr = lane & 15, fq = lane >> 4;
    const int K = g.K, nt = K / BK;
    unsigned voffA[2], voffB[2];
#pragma unroll
    for (int i = 0; i < 2; ++i) { int R, C; stage_rc(tid * 16 + i * 8192, R, C); const int Rb = Epi::PERM ? ((R & ~31) + perm32(R & 31)) : R;
        voffA[i] = (unsigned)(R * K + C) * 2u; voffB[i] = (unsigned)(Rb * K + C) * 2u; }
    const size_t kstep = (size_t)(BK * 2);
    const size_t hstep = (size_t)HALF * K * 2;
    const size_t tstep = 2 * hstep;
    const unsigned ldsw = (unsigned)wid * 1024u;
    const int aoff = lds_byte(wr * 64 + fr, fq * 8), boff = lds_byte(wc * 32 + fr, fq * 8);
#define PG8_SA(b, h) (((b) * 2 + (h)) * HTB)
#define PG8_SB(b, h) ((4 + (b) * 2 + (h)) * HTB)
#define PG8_STAGE(bufoff, gbase, voff) do { _Pragma("unroll") for (int _i = 0; _i < 2; ++_i) \
        __builtin_amdgcn_global_load_lds((const unsigned*)((const char*)(gbase) + (voff)[_i]), (PG8_LAS unsigned*)(lds + (bufoff) + ldsw + _i * 8192), 16, 0, 0); } while (0)
#define PG8_LDA(dst, b, h) do { _Pragma("unroll") for (int m = 0; m < 4; ++m) _Pragma("unroll") for (int k = 0; k < 2; ++k) dst[m][k] = *(const PG8_LAS bf16x8*)(lds + PG8_SA(b, h) + aoff + m * 2048 + k * 1024); } while (0)
#define PG8_LDB(dst, b, h) do { _Pragma("unroll") for (int n = 0; n < 2; ++n) _Pragma("unroll") for (int k = 0; k < 2; ++k) dst[n][k] = *(const PG8_LAS bf16x8*)(lds + PG8_SB(b, h) + boff + n * 2048 + k * 1024); } while (0)
#define PG8_MMA(ai, bj, At, Bt) do { __builtin_amdgcn_s_setprio(1); _Pragma("unroll") for (int m = 0; m < 4; ++m) _Pragma("unroll") for (int n = 0; n < 2; ++n) _Pragma("unroll") for (int k = 0; k < 2; ++k) \
        acc[ai][bj][m][n] = __builtin_amdgcn_mfma_f32_16x16x32_bf16(Bt[n][k], At[m][k], acc[ai][bj][m][n], 0, 0, 0); __builtin_amdgcn_s_setprio(0); } while (0)
#define PG8_WAIT_V(n) asm volatile("s_waitcnt vmcnt(" #n ")" ::: "memory")
#define PG8_WAIT_L(n) asm volatile("s_waitcnt lgkmcnt(" #n ")" ::: "memory")
#define PG8_BAR __builtin_amdgcn_s_barrier()
#define PG8_SCHED __builtin_amdgcn_sched_barrier(0)
    Unit cur, nxt; int ui = 0;
    if (!S.next(0, cur)) return;
    f32x4 acc[2][2][4][2];
#pragma unroll
    for (int a = 0; a < 2; ++a)
#pragma unroll
        for (int b = 0; b < 2; ++b)
#pragma unroll
            for (int m = 0; m < 4; ++m)
#pragma unroll
                for (int n = 0; n < 2; ++n) acc[a][b][m][n] = (f32x4){0.f, 0.f, 0.f, 0.f};
    bf16x8 At[4][2], B0[2][2], B1[2][2];
    const char* cA = (const char*)g.A + (size_t)cur.pm * tstep; const char* cB = (const char*)g.Bt + (size_t)cur.pn * tstep;
    S.a_ready(cur);
    if constexpr (SP2) {
        PG8_STAGE(PG8_SB(0, 0), cB, voffB); PG8_STAGE(PG8_SB(0, 1), cB + hstep, voffB); PG8_STAGE(PG8_SA(0, 0), cA, voffA); PG8_STAGE(PG8_SA(0, 1), cA + hstep, voffA);
        if (wr == 1) PG8_BAR;
        PG8_WAIT_V(2); PG8_BAR;
        PG8_STAGE(PG8_SB(1, 0), cB + kstep, voffB); PG8_STAGE(PG8_SA(1, 0), cA + kstep, voffA); PG8_STAGE(PG8_SB(1, 1), cB + hstep + kstep, voffB);
        PG8_WAIT_V(6); PG8_BAR;
    } else {
        PG8_STAGE(PG8_SB(0, 0), cB, voffB); PG8_STAGE(PG8_SA(0, 0), cA, voffA); PG8_STAGE(PG8_SB(0, 1), cB + hstep, voffB); PG8_STAGE(PG8_SA(0, 1), cA + hstep, voffA);
        if (wr == 1) PG8_BAR;
        PG8_WAIT_V(4); PG8_BAR;
        PG8_STAGE(PG8_SB(1, 0), cB + kstep, voffB); PG8_STAGE(PG8_SA(1, 0), cA + kstep, voffA); PG8_STAGE(PG8_SB(1, 1), cB + hstep + kstep, voffB);
        PG8_WAIT_V(6); PG8_BAR;
    }
    for (;;) {
        const bool has_next = S.next(ui + 1, nxt);
        const char* nA = has_next ? (const char*)g.A + (size_t)nxt.pm * tstep : cA; const char* nB = has_next ? (const char*)g.Bt + (size_t)nxt.pn * tstep : cB;
        for (int t = 0; t < nt; t += 2) {
            const bool last = (t == nt - 2);
            const char* a1 = cA + (size_t)(t + 1) * kstep;
            const char* a2 = last ? nA : cA + (size_t)(t + 2) * kstep; const char* b2 = last ? nB : cB + (size_t)(t + 2) * kstep;
            const char* a3 = a2 + kstep; const char* b3 = b2 + kstep;
            if (last && has_next) S.a_ready(nxt);
            if constexpr (SP2) {
            PG8_LDB(B0, 0, 0); PG8_LDB(B1, 0, 1); PG8_SCHED; PG8_LDA(At, 0, 0); PG8_STAGE(PG8_SA(1, 1), a1 + hstep, voffA);
            PG8_WAIT_V(8); PG8_WAIT_L(0); PG8_BAR; PG8_MMA(0, 0, At, B0); PG8_MMA(0, 1, At, B1); PG8_BAR; PG8_SCHED;
            PG8_LDA(At, 0, 1); PG8_STAGE(PG8_SB(0, 0), b2, voffB); PG8_STAGE(PG8_SB(0, 1), b2 + hstep, voffB); PG8_STAGE(PG8_SA(0, 0), a2, voffA);
            PG8_WAIT_V(8); PG8_WAIT_L(0); PG8_BAR; PG8_MMA(1, 0, At, B0); PG8_MMA(1, 1, At, B1); PG8_BAR; PG8_SCHED;
            PG8_LDB(B0, 1, 0); PG8_LDB(B1, 1, 1); PG8_SCHED; PG8_LDA(At, 1, 0); PG8_STAGE(PG8_SA(0, 1), a2 + hstep, voffA);
            PG8_WAIT_V(8); PG8_WAIT_L(0); PG8_BAR; PG8_MMA(0, 0, At, B0); PG8_MMA(0, 1, At, B1); PG8_BAR; PG8_SCHED;
            PG8_LDA(At, 1, 1); PG8_STAGE(PG8_SB(1, 0), b3, voffB); PG8_STAGE(PG8_SB(1, 1), b3 + hstep, voffB); PG8_STAGE(PG8_SA(1, 0), a3, voffA);
            PG8_WAIT_V(8); PG8_WAIT_L(0); PG8_BAR; PG8_MMA(1, 0, At, B0); PG8_MMA(1, 1, At, B1); PG8_BAR; PG8_SCHED;
            } else {
            PG8_LDB(B0, 0, 0); PG8_SCHED; PG8_LDA(At, 0, 0); PG8_STAGE(PG8_SA(1, 1), a1 + hstep, voffA);
            PG8_WAIT_L(8); PG8_BAR; PG8_WAIT_L(0); PG8_MMA(0, 0, At, B0); PG8_BAR; PG8_SCHED;
            PG8_LDB(B1, 0, 1); PG8_STAGE(PG8_SB(0, 0), b2, voffB);
            PG8_BAR; PG8_WAIT_L(0); PG8_MMA(0, 1, At, B1); PG8_BAR;
            PG8_LDA(At, 0, 1); PG8_STAGE(PG8_SA(0, 0), a2, voffA);
            PG8_BAR; PG8_WAIT_L(0); PG8_MMA(1, 0, At, B0); PG8_BAR; PG8_SCHED;
            PG8_STAGE(PG8_SB(0, 1), b2 + hstep, voffB);
            PG8_WAIT_V(6); PG8_BAR; PG8_MMA(1, 1, At, B1); PG8_BAR;
            PG8_LDB(B0, 1, 0); PG8_SCHED; PG8_LDA(At, 1, 0); PG8_STAGE(PG8_SA(0, 1), a2 + hstep, voffA);
            PG8_WAIT_L(8); PG8_BAR; PG8_WAIT_L(0); PG8_MMA(0, 0, At, B0); PG8_BAR; PG8_SCHED;
            PG8_LDB(B1, 1, 1); PG8_STAGE(PG8_SB(1, 0), b3, voffB);
            PG8_BAR; PG8_WAIT_L(0); PG8_MMA(0, 1, At, B1); PG8_BAR;
            PG8_LDA(At, 1, 1); PG8_STAGE(PG8_SA(1, 0), a3, voffA);
            PG8_BAR; PG8_WAIT_L(0); PG8_MMA(1, 0, At, B0); PG8_BAR; PG8_SCHED;
            PG8_STAGE(PG8_SB(1, 1), b3 + hstep, voffB);
            PG8_WAIT_V(6); PG8_BAR; PG8_MMA(1, 1, At, B1); PG8_BAR;
            }
        }
        if constexpr (ALIGN_EPI) { if (wr == 0) PG8_BAR; }
        if constexpr (!Epi::AFTER_DRAIN) { E(acc, cur, wr, wc, fr, fq); S.done(cur); }
        if (!has_next) break;
#pragma unroll
        for (int a = 0; a < 2; ++a)
#pragma unroll
            for (int b = 0; b < 2; ++b)
#pragma unroll
                for (int m = 0; m < 4; ++m)
#pragma unroll
                    for (int n = 0; n < 2; ++n) acc[a][b][m][n] = (f32x4){0.f, 0.f, 0.f, 0.f};
        cur = nxt; cA = nA; cB = nB; ++ui;
        if constexpr (ALIGN_EPI) { if (wr == 1) PG8_BAR; }
    }
    PG8_WAIT_V(0);
    if constexpr (!ALIGN_EPI) { if (wr == 0) PG8_BAR; }
    PG8_BAR;
    if constexpr (Epi::AFTER_DRAIN) { E.fused(acc, cur, wr, wc, fr, fq, lds, wid, lane); S.done(cur); }
#undef PG8_SA
#undef PG8_SB
#undef PG8_STAGE
#undef PG8_LDA
#undef PG8_LDB
#undef PG8_MMA
#undef PG8_WAIT_V
#undef PG8_WAIT_L
#undef PG8_BAR
#undef PG8_SCHED
}
}
constexpr int NB = 8, T = 4096, D = 1024, M = NB * T, FF = 2816, NIN = 3840, IN_TOTAL = 3672;
constexpr int PC_GQ = 0, PC_GK = 256, PC_GV = 512, PC_GG = 1024, PC_DQ = 1536, PC_DK = 2048, PC_DV = 2560, PC_IQ = 3072, PC_IK = 3584, PC_GA = 3648, PC_IW = 3664;
constexpr float LN_EPS = 1e-5f, RMS_EPS = 1e-6f;
constexpr float ALPHA = 1.189207115002721f;
constexpr size_t MiB = 1u << 20;
constexpr size_t WS_W1GU = 2 * MiB, WS_W1D = 13 * MiB, WS_WIN = 19 * MiB, WS_WOUT = 27 * MiB, WS_W2GU = 29 * MiB, WS_W2D = 40 * MiB;
constexpr size_t WS_XB = 50 * MiB, WS_H = 114 * MiB, WS_Y = 290 * MiB, WS_P = 114 * MiB, WS_U = 354 * MiB, WS_O = 418 * MiB, WS_PM = 482 * MiB, WS_G = 498 * MiB, WS_END = 499 * MiB;
constexpr int LDS_BYTES = 147456;
constexpr int NTHREADS = 512;

#define LAS __attribute__((address_space(3)))
typedef unsigned short bf16;
typedef float f32x4 __attribute__((ext_vector_type(4)));
typedef float f32x16 __attribute__((ext_vector_type(16)));
typedef short bf16x8 __attribute__((ext_vector_type(8)));
typedef unsigned u32x4 __attribute__((ext_vector_type(4)));
typedef unsigned u32x2 __attribute__((ext_vector_type(2)));

__device__ __forceinline__ unsigned f2bf(float f) { unsigned u = __builtin_bit_cast(unsigned, f); return (u + 0x7fffu + ((u >> 16) & 1u)) >> 16; }
__device__ __forceinline__ unsigned pk2(float lo, float hi) { return f2bf(lo) | (f2bf(hi) << 16); }
__device__ __forceinline__ float bf2f(unsigned short b) { return __builtin_bit_cast(float, (unsigned)b << 16); }
__device__ __forceinline__ float bflo(unsigned w) { return __builtin_bit_cast(float, w << 16); }
__device__ __forceinline__ float bfhi(unsigned w) { return __builtin_bit_cast(float, w & 0xffff0000u); }
__device__ __forceinline__ float silu(float g) { return g * __builtin_amdgcn_rcpf(1.0f + __expf(-g)); }
__device__ __forceinline__ float wave_sum(float v) {
#pragma unroll
    for (int o = 1; o < 64; o <<= 1) v += __shfl_xor(v, o);
    return v;
}
#define MFMA32(a, b, c) __builtin_amdgcn_mfma_f32_32x32x16_bf16((a), (b), (c), 0, 0, 0)
__device__ __forceinline__ int perm64(int k) { return (k & 32) | (k & 16) | (((k >> 2) & 1) << 3) | (((k >> 3) & 1) << 2) | (k & 3); }

struct MapId { __device__ __forceinline__ int operator()(int n) const { return n; } };
struct MapGU { __device__ __forceinline__ int operator()(int n) const { const int pn = n >> 8, bj = (n >> 7) & 1, j = n & 127; return bj * FF + pn * 128 + j; } };
struct MapIn { __device__ __forceinline__ int operator()(int n) const {
    if (n < 1536) return n;
    if (n < 3584) return n + 16;
    if (n < 3648) return 3600 + (n - 3584);
    if (n < 3664) return 1536 + (n - 3648);
    if (n < 3672) return 3664 + (n - 3664);
    return -1; } };
template <class Map>
__device__ __forceinline__ void transpose_item(const float* W, int K, int N, int ND, bf16* WT, LAS float* scr, int item, int lane, Map map) {
    const int nblk = ND / 32, kb = item / nblk, nb = item % nblk, k0 = 64 * kb, n0 = 32 * nb;
    const int src = map(n0 + (lane & 31));
#pragma unroll 8
    for (int i = 0; i < 32; ++i) { const int kk = 2 * i + (lane >> 5); scr[kk * 33 + (lane & 31)] = src >= 0 ? W[(size_t)(k0 + kk) * N + src] : 0.f; }
    asm volatile("s_waitcnt lgkmcnt(0)" ::: "memory");
    const int c = lane & 7;
#pragma unroll
    for (int j = 0; j < 4; ++j) { const int n = (lane >> 3) + 8 * j; const LAS float* s = scr + (8 * c) * 33 + n;
        u32x4 o; o.x = pk2(s[0 * 33], s[1 * 33]); o.y = pk2(s[2 * 33], s[3 * 33]); o.z = pk2(s[4 * 33], s[5 * 33]); o.w = pk2(s[6 * 33], s[7 * 33]);
        *(u32x4*)(WT + (size_t)(n0 + n) * K + k0 + 8 * c) = o; }
    asm volatile("s_waitcnt lgkmcnt(0)" ::: "memory");
}

__device__ __forceinline__ void ln_rows(const float* Y, const float* g, const float* be, float* Xf, bf16* Xb, int gw, int NGW, int lane) {
    f32x4 gv[4], bv[4];
#pragma unroll
    for (int j = 0; j < 4; ++j) { gv[j] = ((const f32x4*)g)[64 * j + lane]; bv[j] = ((const f32x4*)be)[64 * j + lane]; }
    for (int m = gw; m < M; m += NGW) {
        const f32x4* xr = (const f32x4*)(Y + (size_t)m * D) + lane;
        f32x4 v[4]; float s = 0.f;
#pragma unroll
        for (int j = 0; j < 4; ++j) { v[j] = xr[64 * j]; s += (v[j].x + v[j].y) + (v[j].z + v[j].w); }
        const float mean = wave_sum(s) * (1.f / D); float s2 = 0.f;
#pragma unroll
        for (int j = 0; j < 4; ++j) { v[j] = v[j] - mean; s2 += (v[j].x * v[j].x + v[j].y * v[j].y) + (v[j].z * v[j].z + v[j].w * v[j].w); }
        const float rstd = 1.f / sqrtf(wave_sum(s2) * (1.f / D) + LN_EPS);
#pragma unroll
        for (int j = 0; j < 4; ++j) { const f32x4 o = v[j] * rstd * gv[j] + bv[j];
            if (Xf) ((f32x4*)(Xf + (size_t)m * D))[64 * j + lane] = o;
            if (Xb) { u32x2 w; w.x = pk2(o.x, o.y); w.y = pk2(o.z, o.w); ((u32x2*)(Xb + (size_t)m * D))[64 * j + lane] = w; } }
    }
}

constexpr int GL_BL = 0, GL_SEGT = 16640, GL_QS = 18688, GL_KS = GL_QS + 9216, GL_VT = GL_KS + 9216, GL_ST = GL_VT + 18432, GL_RED = GL_ST + 18432, GL_END = GL_RED + 1024;
__device__ __forceinline__ void gla_b(LAS unsigned char* lds, const float* PM, const float* w2, const float* ba, int row0, int h, int tid) {
    LAS float* BL = (LAS float*)(lds + GL_BL); LAS float* SEGT = (LAS float*)(lds + GL_SEGT);
    const int d = tid & 63, seg = tid >> 6;
    float wcol[16];
#pragma unroll
    for (int r = 0; r < 16; ++r) wcol[r] = w2[r * 256 + h * 64 + d];
    const float bias = ba[h * 64 + d];
    float pre[8]; float run = 0.f;
#pragma unroll
    for (int t = 0; t < 8; ++t) { const float* ga = PM + (size_t)(row0 + seg * 8 + t) * 128 + 64; float z = bias;
#pragma unroll
        for (int r = 0; r < 16; ++r) z += ga[r] * wcol[r];
        const float ls = fminf(z, 0.f) - __logf(1.0f + __expf(-fabsf(z)));
        run += ls * (1.f / 16.f); pre[t] = run; }
    SEGT[seg * 64 + d] = run;
    __syncthreads();
    float off = 0.f;
#pragma unroll
    for (int s = 0; s < 8; ++s) off += (s < seg) ? SEGT[s * 64 + d] : 0.f;
#pragma unroll
    for (int t = 0; t < 8; ++t) BL[(seg * 8 + t) * 65 + d] = pre[t] + off;
    __syncthreads();
}
__device__ __forceinline__ void gla_stage_vt(LAS unsigned char* lds, const bf16* P, int row0, int h, int tid) {
    LAS bf16* VT = (LAS bf16*)(lds + GL_VT);
#pragma unroll
    for (int i = 0; i < 2; ++i) { const int piece = tid + i * NTHREADS, j = piece >> 4, c = piece & 15, pj = perm64(j);
        const u32x4 v = *(const u32x4*)(P + (size_t)(row0 + j) * NIN + PC_GV + h * 128 + c * 8);
        VT[(c * 8 + 0) * 72 + pj] = (bf16)(v.x & 0xffff); VT[(c * 8 + 1) * 72 + pj] = (bf16)(v.x >> 16);
        VT[(c * 8 + 2) * 72 + pj] = (bf16)(v.y & 0xffff); VT[(c * 8 + 3) * 72 + pj] = (bf16)(v.y >> 16);
        VT[(c * 8 + 4) * 72 + pj] = (bf16)(v.z & 0xffff); VT[(c * 8 + 5) * 72 + pj] = (bf16)(v.z >> 16);
        VT[(c * 8 + 6) * 72 + pj] = (bf16)(v.w & 0xffff); VT[(c * 8 + 7) * 72 + pj] = (bf16)(v.w >> 16); }
}
__device__ __forceinline__ void gla_g1_item(LAS unsigned char* lds, const bf16* P, const float* PM, const float* w2, const float* ba, float* U, float* G, int item, int tid) {
    const int bh = item >> 6, n = item & 63, b = bh >> 2, h = bh & 3, row0 = b * T + n * 64;
    const int lane = tid & 63, wave = tid >> 6, l32 = lane & 31, hi = lane >> 5;
    gla_b(lds, PM, w2, ba, row0, h, tid);
    LAS float* BL = (LAS float*)(lds + GL_BL); LAS bf16* KHT = (LAS bf16*)(lds + GL_QS); LAS bf16* VT = (LAS bf16*)(lds + GL_VT);
    { const int j = tid >> 3, dg = tid & 7, pj = perm64(j);
      const u32x4 kv = *(const u32x4*)(P + (size_t)(row0 + j) * NIN + PC_GK + h * 64 + dg * 8);
      const unsigned kw[4] = {kv.x, kv.y, kv.z, kv.w};
#pragma unroll
      for (int e = 0; e < 8; ++e) { const int d = dg * 8 + e; const float kf = (e & 1) ? bfhi(kw[e >> 1]) : bflo(kw[e >> 1]);
          KHT[d * 72 + pj] = (bf16)f2bf(kf * __expf(BL[63 * 65 + d] - BL[j * 65 + d])); } }
    gla_stage_vt(lds, P, row0, h, tid);
    __syncthreads();
    { const int dvt = wave & 3, dt = wave >> 2;
      f32x16 acc;
#pragma unroll
      for (int r = 0; r < 16; ++r) acc[r] = 0.f;
#pragma unroll
      for (int s = 0; s < 4; ++s) { const bf16x8 a = *(const LAS bf16x8*)(VT + (dvt * 32 + l32) * 72 + s * 16 + hi * 8); const bf16x8 bb = *(const LAS bf16x8*)(KHT + (dt * 32 + l32) * 72 + s * 16 + hi * 8);
          acc = MFMA32(a, bb, acc); }
#pragma unroll
      for (int r = 0; r < 16; ++r) { const int dv = dvt * 32 + 8 * (r >> 2) + 4 * hi + (r & 3); U[((size_t)item * 128 + dv) * 64 + dt * 32 + l32] = acc[r]; } }
    if (tid < 64) G[item * 64 + tid] = __expf(BL[63 * 65 + tid]);
    __syncthreads();
}
__device__ __forceinline__ void gla_g3_item(LAS unsigned char* lds, const bf16* P, const float* PM, const float* w2, const float* ba, const float* gnorm, const float* U, bf16* O, int item, int tid) {
    const int bh = item >> 6, n = item & 63, b = bh >> 2, h = bh & 3, row0 = b * T + n * 64;
    const int lane = tid & 63, wave = tid >> 6, l32 = lane & 31, hi = lane >> 5;
    gla_b(lds, PM, w2, ba, row0, h, tid);
    LAS float* BL = (LAS float*)(lds + GL_BL); LAS bf16* QS = (LAS bf16*)(lds + GL_QS); LAS bf16* KS = (LAS bf16*)(lds + GL_KS);
    LAS bf16* VT = (LAS bf16*)(lds + GL_VT); LAS bf16* ST = (LAS bf16*)(lds + GL_ST); LAS float* RED = (LAS float*)(lds + GL_RED);
    { const int i = tid >> 3, dg = tid & 7;
      const u32x4 qv = *(const u32x4*)(P + (size_t)(row0 + i) * NIN + PC_GQ + h * 64 + dg * 8);
      const u32x4 kv = *(const u32x4*)(P + (size_t)(row0 + i) * NIN + PC_GK + h * 64 + dg * 8);
      const unsigned qw[4] = {qv.x, qv.y, qv.z, qv.w}, kw[4] = {kv.x, kv.y, kv.z, kv.w};
      unsigned qo[4], ko[4];
#pragma unroll
      for (int e2 = 0; e2 < 4; ++e2) { const float b0 = BL[i * 65 + dg * 8 + 2 * e2], b1 = BL[i * 65 + dg * 8 + 2 * e2 + 1];
          qo[e2] = pk2(bflo(qw[e2]) * __expf(b0) * 0.125f, bfhi(qw[e2]) * __expf(b1) * 0.125f);
          ko[e2] = pk2(bflo(kw[e2]) * __expf(-b0), bfhi(kw[e2]) * __expf(-b1)); }
      *(LAS u32x4*)(QS + i * 72 + dg * 8) = (u32x4){qo[0], qo[1], qo[2], qo[3]};
      *(LAS u32x4*)(KS + i * 72 + dg * 8) = (u32x4){ko[0], ko[1], ko[2], ko[3]}; }
    gla_stage_vt(lds, P, row0, h, tid);
#pragma unroll
    for (int i = 0; i < 4; ++i) { const int idx4 = tid + i * NTHREADS, dv = idx4 >> 4, d4 = (idx4 & 15) * 4;
        const f32x4 s = *(const f32x4*)(U + ((size_t)item * 128 + dv) * 64 + d4);
        *(LAS u32x2*)(ST + dv * 72 + d4) = (u32x2){pk2(s.x, s.y), pk2(s.z, s.w)}; }
    __syncthreads();
    const int dvt = wave & 3, it = wave >> 2;
    f32x16 o;
    {
      bf16x8 qfr[4];
#pragma unroll
      for (int s = 0; s < 4; ++s) qfr[s] = *(const LAS bf16x8*)(QS + (it * 32 + l32) * 72 + s * 16 + hi * 8);
      bf16x8 pf[2][2];
#pragma unroll
      for (int jt = 0; jt < 2; ++jt) { f32x16 a;
#pragma unroll
          for (int r = 0; r < 16; ++r) a[r] = 0.f;
#pragma unroll
          for (int s = 0; s < 4; ++s) { const bf16x8 kf = *(const LAS bf16x8*)(KS + (jt * 32 + l32) * 72 + s * 16 + hi * 8); a = MFMA32(kf, qfr[s], a); }
          const int i = it * 32 + l32;
#pragma unroll
          for (int r = 0; r < 16; ++r) { const int j = jt * 32 + 8 * (r >> 2) + 4 * hi + (r & 3); a[r] = (j <= i) ? a[r] : 0.f; }
#pragma unroll
          for (int s2 = 0; s2 < 2; ++s2) { u32x4 w; w.x = pk2(a[8 * s2 + 0], a[8 * s2 + 1]); w.y = pk2(a[8 * s2 + 2], a[8 * s2 + 3]); w.z = pk2(a[8 * s2 + 4], a[8 * s2 + 5]); w.w = pk2(a[8 * s2 + 6], a[8 * s2 + 7]);
              pf[jt][s2] = __builtin_bit_cast(bf16x8, w); } }
#pragma unroll
      for (int r = 0; r < 16; ++r) o[r] = 0.f;
#pragma unroll
      for (int jt = 0; jt < 2; ++jt)
#pragma unroll
          for (int s2 = 0; s2 < 2; ++s2) { const bf16x8 vf = *(const LAS bf16x8*)(VT + (dvt * 32 + l32) * 72 + jt * 32 + s2 * 16 + hi * 8); o = MFMA32(vf, pf[jt][s2], o); }
#pragma unroll
      for (int s = 0; s < 4; ++s) { const bf16x8 sf = *(const LAS bf16x8*)(ST + (dvt * 32 + l32) * 72 + s * 16 + hi * 8); o = MFMA32(sf, qfr[s], o); }
    }
    float ss = 0.f;
#pragma unroll
    for (int r = 0; r < 16; ++r) ss += o[r] * o[r];
    ss += __shfl_xor(ss, 32);
    if (hi == 0) RED[dvt * 64 + it * 32 + l32] = ss;
    __syncthreads();
    { const int i = it * 32 + l32; const float tot = RED[i] + RED[64 + i] + RED[128 + i] + RED[192 + i];
      const float rs = 1.0f / sqrtf(tot * (1.f / 128.f) + RMS_EPS);
#pragma unroll
      for (int g = 0; g < 4; ++g) { const int dv0 = dvt * 32 + 8 * g + 4 * hi;
          const u32x2 gg = *(const u32x2*)(P + (size_t)(row0 + i) * NIN + PC_GG + h * 128 + dv0);
          const f32x4 gn = *(const f32x4*)(gnorm + dv0);
          const float o0 = o[4 * g + 0] * rs * gn.x * silu(bflo(gg.x)), o1 = o[4 * g + 1] * rs * gn.y * silu(bfhi(gg.x));
          const float o2 = o[4 * g + 2] * rs * gn.z * silu(bflo(gg.y)), o3 = o[4 * g + 3] * rs * gn.w * silu(bfhi(gg.y));
          *(u32x2*)(O + (size_t)(row0 + i) * D + h * 128 + dv0) = (u32x2){pk2(o0, o1), pk2(o2, o3)}; } }
    __syncthreads();
}
__device__ __forceinline__ void vt_item(LAS unsigned char* lds, bf16* P, int item, int tid) {
    const int row0 = item * 64;
    LAS bf16* LV = (LAS bf16*)lds;
#pragma unroll
    for (int i = 0; i < 8; ++i) { const int piece = tid + i * NTHREADS, key = piece >> 6, c16 = piece & 63;
        *(LAS u32x4*)(LV + key * 520 + c16 * 8) = *(const u32x4*)(P + (size_t)(row0 + key) * NIN + PC_DV + c16 * 8); }
    __syncthreads();
    const int col = tid; bf16* dst = P + (size_t)(row0 + (col >> 3)) * NIN + PC_DV + (col & 7) * 64;
#pragma unroll
    for (int pg = 0; pg < 8; ++pg) { unsigned e[8];
#pragma unroll
        for (int jj = 0; jj < 8; ++jj) { const int pos = pg * 8 + jj; const int key = (pos & 32) + (pos & 16) + 8 * (jj >> 2) + 4 * ((pos >> 3) & 1) + (jj & 3); e[jj] = LV[key * 520 + col]; }
        *(u32x4*)(dst + pg * 8) = (u32x4){e[0] | (e[1] << 16), e[2] | (e[3] << 16), e[4] | (e[5] << 16), e[6] | (e[7] << 16)}; }
    __syncthreads();
}

__device__ __forceinline__ unsigned okey(float x) { unsigned bits = __builtin_bit_cast(unsigned, x); if (bits == 0x80000000u) bits = 0u; return bits ^ ((unsigned)((int)bits >> 31) | 0x80000000u); }
__device__ __forceinline__ void dsa_item(LAS unsigned char* lds, const bf16* P, const float* PM, bf16* O, float* scr, int b, int c, int tid) {
    LAS unsigned* BMK = (LAS unsigned*)lds;
    const int lane = tid & 63, wave = __builtin_amdgcn_readfirstlane(tid >> 6), l32 = lane & 31, hi = lane >> 5;
    const int row0 = b * T + c * 64, nk64 = c + 1;
    const bf16* Kb = P + (size_t)(b * T) * NIN;
    for (int rt = 0; rt < 2; ++rt) {
        const int qbase = row0 + wave * 8 + rt * 4;
        {
            bf16x8 qf[4];
            { const int hh = l32 >> 2, q = l32 & 3; const bf16* qp = P + (size_t)(qbase + q) * NIN + PC_IQ + hh * 64 + hi * 8;
#pragma unroll
              for (int s = 0; s < 4; ++s) qf[s] = *(const bf16x8*)(qp + s * 16); }
            float w[4][4];
#pragma unroll
            for (int q = 0; q < 4; ++q)
#pragma unroll
                for (int g = 0; g < 4; ++g) w[q][g] = PM[(size_t)(qbase + q) * 128 + 80 + 2 * g + hi] * (0.125f * 0.35355339059327373f);
            const int ntile = 2 * nk64;
            bf16x8 kf[4];
            { const bf16* kp = Kb + (size_t)l32 * NIN + PC_IK + hi * 8;
#pragma unroll
              for (int s = 0; s < 4; ++s) kf[s] = *(const bf16x8*)(kp + s * 16); }
            for (int kt = 0; kt < ntile; ++kt) {
                bf16x8 kn[4];
                { const int ktn = (kt + 1 < ntile) ? kt + 1 : kt; const bf16* kp = Kb + (size_t)(ktn * 32 + l32) * NIN + PC_IK + hi * 8;
#pragma unroll
                  for (int s = 0; s < 4; ++s) kn[s] = *(const bf16x8*)(kp + s * 16); }
                f32x16 acc;
#pragma unroll
                for (int r = 0; r < 16; ++r) acc[r] = 0.f;
#pragma unroll
                for (int s = 0; s < 4; ++s) acc = MFMA32(qf[s], kf[s], acc);
                float part[4];
#pragma unroll
                for (int q = 0; q < 4; ++q) { float p = 0.f;
#pragma unroll
                    for (int g = 0; g < 4; ++g) p += w[q][g] * fmaxf(acc[4 * g + q], 0.f);
                    part[q] = p + __shfl_xor(p, 32); }
                const float a0 = hi ? part[2] : part[0], a1 = hi ? part[3] : part[1];
                scr[(2 * hi) * 4096 + kt * 32 + l32] = a0; scr[(2 * hi + 1) * 4096 + kt * 32 + l32] = a1;
#pragma unroll
                for (int s = 0; s < 4; ++s) kf[s] = kn[s];
            }
        }
        __builtin_amdgcn_fence(__ATOMIC_RELEASE, "workgroup"); asm volatile("s_waitcnt vmcnt(0)" ::: "memory");
        __builtin_amdgcn_fence(__ATOMIC_ACQUIRE, "workgroup");
        for (int q = 0; q < 4; ++q) {
            LAS unsigned* bmrow = BMK + (wave * 8 + rt * 4 + q) * 129;
            if (c < 4) {
                for (int j = 0; j <= c; ++j) if (lane < 2) bmrow[2 * j + lane] = 0xffffffffu;
            } else {
                unsigned kx[64];
#pragma unroll
                for (int g = 0; g < 4; ++g) {
                    if (g * 16 <= c) {
#pragma unroll
                        for (int jj = 0; jj < 16; ++jj) { const int j = g * 16 + jj; unsigned bits = __builtin_bit_cast(unsigned, scr[q * 4096 + j * 64 + lane]); if (bits == 0x80000000u) bits = 0u; kx[j] = (j <= c) ? bits : 0xff800000u; }
                    } else {
#pragma unroll
                        for (int jj = 0; jj < 16; ++jj) kx[g * 16 + jj] = 0xff800000u;
                    }
                }
                LAS unsigned* HIST = (LAS unsigned*)(lds + 33280 + wave * 6656); LAS unsigned* LIST = HIST + 1024; LAS unsigned* DENSE = LIST + 512;
#pragma unroll
                for (int i = 0; i < 4; ++i) *(LAS u32x4*)(HIST + i * 256 + lane * 4) = (u32x4){0u, 0u, 0u, 0u};
#pragma unroll
                for (int g = 0; g < 4; ++g) if (g * 16 <= c) {
#pragma unroll
                    for (int jj = 0; jj < 16; ++jj) { int bi = (int)__builtin_fmaf(__builtin_bit_cast(float, kx[g * 16 + jj]), 64.f, 512.f); bi = min(max(bi, 0), 1023);
                        __hip_atomic_fetch_add(HIST + bi, 1u, __ATOMIC_RELAXED, __HIP_MEMORY_SCOPE_WORKGROUP); }
                }
                int bstar, nb, cabove;
                { unsigned hs[16];
#pragma unroll
                  for (int i = 0; i < 4; ++i) { const u32x4 v = *(const LAS u32x4*)(HIST + lane * 16 + i * 4); hs[4 * i] = v.x; hs[4 * i + 1] = v.y; hs[4 * i + 2] = v.z; hs[4 * i + 3] = v.w; }
                  unsigned tl = 0;
#pragma unroll
                  for (int i = 0; i < 16; ++i) tl += hs[i];
                  unsigned incl = tl;
#pragma unroll
                  for (int o = 1; o < 64; o <<= 1) { const unsigned t = __shfl_down(incl, o); incl += (lane + o < 64) ? t : 0u; }
                  const unsigned above = incl - tl;
                  const unsigned long long own = __ballot(above < 256u && incl >= 256u);
                  unsigned cum = above; int lb = 0, lnb = 0, lca = 0; bool found = false;
#pragma unroll
                  for (int i = 15; i >= 0; --i) { const bool hit = !found && (cum + hs[i] >= 256u); lb = hit ? i : lb; lnb = hit ? (int)hs[i] : lnb; lca = hit ? (int)cum : lca; found = found || hit; cum += hs[i]; }
                  const int ol = own ? (int)__builtin_ctzll(own) : 0;
                  bstar = __shfl(lb, ol) + 16 * ol; nb = __shfl(lnb, ol); cabove = __shfl(lca, ol);
                  if (!own) bstar = 0; }
                bool fast = (bstar > 0) && (bstar < 1023) && (nb <= 64);
                unsigned thrbits = 0u; int n_ge = 0, need = 256 - cabove; unsigned ck = 0u, thr = 0u;
                if (fast) {
                    unsigned kt = 0;
#pragma unroll
                    for (int g = 0; g < 4; ++g) if (g * 16 <= c) {
#pragma unroll
                        for (int jj = 0; jj < 16; ++jj) { const unsigned v = kx[g * 16 + jj]; int bi = (int)__builtin_fmaf(__builtin_bit_cast(float, v), 64.f, 512.f); bi = min(max(bi, 0), 1023);
                            LIST[min(kt, 7u) * 64 + lane] = v; kt += (bi == bstar) ? 1u : 0u; }
                    }
                    if (__ballot(kt > 8u)) fast = false;
                    else {
                        unsigned incl = kt;
#pragma unroll
                        for (int o = 1; o < 64; o <<= 1) { const unsigned t = __shfl_up(incl, o); incl += (lane >= o) ? t : 0u; }
                        const unsigned off = incl - kt;
#pragma unroll
                        for (int i = 0; i < 8; ++i) if ((unsigned)i < kt) DENSE[off + i] = LIST[i * 64 + lane];
                        const unsigned cb = (lane < nb) ? DENSE[lane] : 0xff800000u;
                        ck = (lane < nb) ? (cb ^ ((unsigned)((int)cb >> 31) | 0x80000000u)) : 0u;
                        for (int bit = 31; bit >= 0; --bit) { const unsigned cand = thr | (1u << bit); if ((int)__popcll(__ballot(ck >= cand)) >= need) thr = cand; }
                        n_ge = (int)__popcll(__ballot(ck >= thr));
                        thrbits = (thr & 0x80000000u) ? (thr ^ 0x80000000u) : ~thr;
                    }
                }
                if (fast) {
                    const float thrf = __builtin_bit_cast(float, thrbits);
                    if (n_ge == need) {
#pragma unroll
                        for (int g = 0; g < 4; ++g) if (g * 16 <= c) {
#pragma unroll
                            for (int jj = 0; jj < 16; ++jj) { const int j = g * 16 + jj; const unsigned long long mm = __ballot(__builtin_bit_cast(float, kx[j]) >= thrf);
                                if (lane < 2) bmrow[2 * j + lane] = lane ? (unsigned)(mm >> 32) : (unsigned)mm; }
                        }
                    } else {
                        int need2 = need - (int)__popcll(__ballot(ck > thr));
#pragma unroll
                        for (int g = 0; g < 4; ++g) if (g * 16 <= c) {
#pragma unroll
                            for (int jj = 0; jj < 16; ++jj) { const int j = g * 16 + jj; const float xv = __builtin_bit_cast(float, kx[j]);
                                const unsigned long long gt = __ballot(xv > thrf); unsigned long long eq = __ballot(xv == thrf);
                                int ne = __popcll(eq);
                                while (ne > need2) { eq &= ~(1ull << (63 - __clzll((long long)eq))); --ne; }
                                need2 -= ne;
                                const unsigned long long mm = gt | eq;
                                if (lane < 2) bmrow[2 * j + lane] = lane ? (unsigned)(mm >> 32) : (unsigned)mm; }
                        }
                    }
                } else {
#pragma unroll
                    for (int j = 0; j < 64; ++j) { const unsigned b = kx[j]; kx[j] = (b == 0xff800000u) ? 0u : (b ^ ((unsigned)((int)b >> 31) | 0x80000000u)); }
                    unsigned cur = 0u;
                    for (int bit = 31; bit >= 0; --bit) {
                        const unsigned cand = cur | (1u << bit); int cnt = 0;
#pragma unroll
                        for (int g = 0; g < 4; ++g) if (g * 16 <= c) {
#pragma unroll
                            for (int jj = 0; jj < 16; ++jj) cnt += __popcll(__ballot(kx[g * 16 + jj] >= cand));
                        }
                        if (cnt >= 256) cur = cand;
                    }
                    int cgt = 0;
#pragma unroll
                    for (int g = 0; g < 4; ++g) if (g * 16 <= c) {
#pragma unroll
                        for (int jj = 0; jj < 16; ++jj) cgt += __popcll(__ballot(kx[g * 16 + jj] > cur));
                    }
                    int need3 = 256 - cgt;
#pragma unroll
                    for (int g = 0; g < 4; ++g) if (g * 16 <= c) {
#pragma unroll
                        for (int jj = 0; jj < 16; ++jj) { const int j = g * 16 + jj;
                            const unsigned long long gt = __ballot(kx[j] > cur); unsigned long long eq = __ballot(kx[j] == cur);
                            int ne = __popcll(eq);
                            while (ne > need3) { eq &= ~(1ull << (63 - __clzll((long long)eq))); --ne; }
                            need3 -= ne;
                            const unsigned long long mm = gt | eq;
                            if (lane < 2) bmrow[2 * j + lane] = lane ? (unsigned)(mm >> 32) : (unsigned)mm; }
                    }
                }
            }
        }
    }
    __syncthreads();
    {
        const int h = wave;
        LAS bf16* QL = (LAS bf16*)(lds + 33280 + wave * 9216);
        { const bf16* qp = P + (size_t)(row0 + lane) * NIN + PC_DQ + h * 64;
#pragma unroll
          for (int pc = 0; pc < 8; ++pc) *(LAS u32x4*)(QL + lane * 72 + pc * 8) = *(const u32x4*)(qp + pc * 8); }
        f32x16 oacc[2][2];
#pragma unroll
        for (int a = 0; a < 2; ++a)
#pragma unroll
            for (int bq = 0; bq < 2; ++bq)
#pragma unroll
                for (int r = 0; r < 16; ++r) oacc[a][bq][r] = 0.f;
        float lsum[2] = {0.f, 0.f};
        const float cs = 0.125f * 1.4426950408889634f;
        const int ntile = 2 * nk64;
        bf16x8 kf[4];
        { const bf16* kp = Kb + (size_t)l32 * NIN + PC_DK + h * 64 + hi * 8;
#pragma unroll
          for (int s = 0; s < 4; ++s) kf[s] = *(const bf16x8*)(kp + s * 16); }
        for (int kt = 0; kt < ntile; ++kt) {
            bf16x8 kn[4], vf[2][2];
#pragma unroll
            for (int dt = 0; dt < 2; ++dt) { const int col = h * 64 + dt * 32 + l32;
                const bf16* vp = Kb + (size_t)((kt >> 1) * 64 + (col >> 3)) * NIN + PC_DV + (col & 7) * 64 + (kt & 1) * 32 + hi * 8;
                vf[dt][0] = *(const bf16x8*)vp; vf[dt][1] = *(const bf16x8*)(vp + 16); }
            { const int ktn = (kt + 1 < ntile) ? kt + 1 : kt;
              const bf16* kp = Kb + (size_t)(ktn * 32 + l32) * NIN + PC_DK + h * 64 + hi * 8;
#pragma unroll
              for (int s = 0; s < 4; ++s) kn[s] = *(const bf16x8*)(kp + s * 16); }
#pragma unroll
            for (int qt = 0; qt < 2; ++qt) {
                f32x16 S;
#pragma unroll
                for (int r = 0; r < 16; ++r) S[r] = 0.f;
#pragma unroll
                for (int s = 0; s < 4; ++s) { const bf16x8 qfr = *(const LAS bf16x8*)(QL + (qt * 32 + l32) * 72 + s * 16 + hi * 8); S = MFMA32(kf[s], qfr, S); }
                const unsigned wsh = BMK[(qt * 32 + l32) * 129 + kt] >> (4 * hi);
                float p[16]; float ls = 0.f;
#pragma unroll
                for (int r = 0; r < 16; ++r) { const int bp = 8 * (r >> 2) + (r & 3); const float e = __builtin_amdgcn_exp2f(S[r] * cs);
                    const int mk = ((int)(wsh << (31 - bp))) >> 31; p[r] = __builtin_bit_cast(float, __builtin_bit_cast(int, e) & mk); ls += p[r]; }
                lsum[qt] += ls;
                bf16x8 pf[2];
#pragma unroll
                for (int s2 = 0; s2 < 2; ++s2) { u32x4 wv; wv.x = pg8::cvt_pk_bf16(p[8 * s2 + 0], p[8 * s2 + 1]); wv.y = pg8::cvt_pk_bf16(p[8 * s2 + 2], p[8 * s2 + 3]); wv.z = pg8::cvt_pk_bf16(p[8 * s2 + 4], p[8 * s2 + 5]); wv.w = pg8::cvt_pk_bf16(p[8 * s2 + 6], p[8 * s2 + 7]);
                    pf[s2] = __builtin_bit_cast(bf16x8, wv); }
#pragma unroll
                for (int dt = 0; dt < 2; ++dt)
#pragma unroll
                    for (int s2 = 0; s2 < 2; ++s2) oacc[dt][qt] = MFMA32(vf[dt][s2], pf[s2], oacc[dt][qt]);
            }
#pragma unroll
            for (int s = 0; s < 4; ++s) kf[s] = kn[s];
        }
#pragma unroll
        for (int qt = 0; qt < 2; ++qt) { const float tot = lsum[qt] + __shfl_xor(lsum[qt], 32); const float inv = 1.0f / tot;
            bf16* orow = O + (size_t)(row0 + qt * 32 + l32) * D + 512 + h * 64;
#pragma unroll
            for (int dt = 0; dt < 2; ++dt)
#pragma unroll
                for (int g = 0; g < 4; ++g) { const int d0 = dt * 32 + 8 * g + 4 * hi;
                    *(u32x2*)(orow + d0) = (u32x2){pk2(oacc[dt][qt][4 * g] * inv, oacc[dt][qt][4 * g + 1] * inv), pk2(oacc[dt][qt][4 * g + 2] * inv, oacc[dt][qt][4 * g + 3] * inv)}; } }
    }
    __syncthreads();
}

struct Args { const float* in[16]; float* out; unsigned char* ws; };
#define PHASE_BEGIN() \
    const __attribute__((address_space(4))) Args* ap = (const __attribute__((address_space(4))) Args*)__builtin_amdgcn_kernarg_segment_ptr(); asm volatile("" : "+s"(ap)); \
    unsigned char* ws = ap->ws; int tid = threadIdx.x; asm volatile("" : "+v"(tid)); \
    const int lane = tid & 63, wave = __builtin_amdgcn_readfirstlane(tid >> 6); const int G = gridDim.x, bx = blockIdx.x; const int gw = bx * 8 + wave, NGW = G * 8; \
    (void)lane; (void)gw; (void)NGW; (void)ws
__global__ void __launch_bounds__(NTHREADS, 2) hymba_fwd(Args args) {
    extern __shared__ __attribute__((aligned(16))) unsigned char lds_raw[];
    LAS unsigned char* lds = (LAS unsigned char*)lds_raw;
    cg::grid_group grid = cg::this_grid();
    {
        PHASE_BEGIN();
        const float* x = ap->in[0]; const float* w_in = ap->in[1]; const float* w_out = ap->in[5];
        const float* f1gu = ap->in[6]; const float* f1d = ap->in[7]; const float* f2gu = ap->in[8]; const float* f2d = ap->in[9];
        bf16 *W1GU = (bf16*)(ws + WS_W1GU), *W1D = (bf16*)(ws + WS_W1D), *WIN = (bf16*)(ws + WS_WIN), *WOUT = (bf16*)(ws + WS_WOUT), *W2GU = (bf16*)(ws + WS_W2GU), *W2D = (bf16*)(ws + WS_W2D);
        bf16* XB = (bf16*)(ws + WS_XB);
        LAS float* scr = (LAS float*)(lds + wave * 16384);
        constexpr int I_GU = (D / 64) * (2 * FF / 32), I_D = (FF / 64) * (D / 32), I_IN = (D / 64) * (NIN / 32), I_OUT = (D / 64) * (D / 32);
        constexpr int NITEMS = 2 * I_GU + 2 * I_D + I_IN + I_OUT;
        for (int it = gw; it < NITEMS; it += NGW) {
            int r = it;
            if (r < I_GU) { transpose_item(f1gu, D, 2 * FF, 2 * FF, W1GU, scr, r, lane, MapGU()); continue; } r -= I_GU;
            if (r < I_GU) { transpose_item(f2gu, D, 2 * FF, 2 * FF, W2GU, scr, r, lane, MapGU()); continue; } r -= I_GU;
            if (r < I_D) { transpose_item(f1d, FF, D, D, W1D, scr, r, lane, MapId()); continue; } r -= I_D;
            if (r < I_D) { transpose_item(f2d, FF, D, D, W2D, scr, r, lane, MapId()); continue; } r -= I_D;
            if (r < I_IN) { transpose_item(w_in, D, IN_TOTAL, NIN, WIN, scr, r, lane, MapIn()); continue; } r -= I_IN;
            transpose_item(w_out, D, D, D, WOUT, scr, r, lane, MapId());
        }
        const size_t n8 = (size_t)M * D / 8;
        for (size_t i = (size_t)bx * NTHREADS + tid; i < n8; i += (size_t)G * NTHREADS) {
            const f32x4 a = ((const f32x4*)x)[2 * i], c = ((const f32x4*)x)[2 * i + 1];
            ((u32x4*)XB)[i] = (u32x4){pk2(a.x, a.y), pk2(a.z, a.w), pk2(c.x, c.y), pk2(c.z, c.w)};
        }
    }
    grid.sync();
    { PHASE_BEGIN(); pg8::Gemm g{(bf16*)(ws + WS_XB), (bf16*)(ws + WS_W1GU), M, 2 * FF, D}; pg8::StaticOrder S; S.init(M, 2 * FF, G, bx); pg8::EpiSwiglu E{(bf16*)(ws + WS_H), FF};
      pg8::gemm_phase<pg8::EpiSwiglu, pg8::StaticOrder, true, true>(lds, g, S, E); }
    grid.sync();
    { PHASE_BEGIN(); pg8::Gemm g{(bf16*)(ws + WS_H), (bf16*)(ws + WS_W1D), M, D, FF}; pg8::StaticOrder S; S.init(M, D, G, bx); pg8::EpiResF32 E{ap->in[0], (float*)(ws + WS_Y), D, ALPHA, 0.5f};
      pg8::gemm_phase<pg8::EpiResF32, pg8::StaticOrder, true, true>(lds, g, S, E); }
    grid.sync();
    { PHASE_BEGIN(); ln_rows((const float*)(ws + WS_Y), ap->in[10], ap->in[11], ap->out, (bf16*)(ws + WS_XB), gw, NGW, lane); }
    grid.sync();
    { PHASE_BEGIN(); pg8::Gemm g{(bf16*)(ws + WS_XB), (bf16*)(ws + WS_WIN), M, NIN, D}; pg8::StaticOrder S; S.init(M, NIN, G, bx); pg8::EpiProj E{(bf16*)(ws + WS_P), NIN, (float*)(ws + WS_PM), NIN / 256 - 1};
      pg8::gemm_phase<pg8::EpiProj, pg8::StaticOrder, true, true>(lds, g, S, E); }
    grid.sync();
    { PHASE_BEGIN();
      for (int it = bx; it < NB * 4 * 64; it += G) gla_g1_item(lds, (const bf16*)(ws + WS_P), (const float*)(ws + WS_PM), ap->in[2], ap->in[3], (float*)(ws + WS_U), (float*)(ws + WS_G), it, tid);
      for (int it = bx; it < NB * 64; it += G) vt_item(lds, (bf16*)(ws + WS_P), it, tid); }
    grid.sync();
    { PHASE_BEGIN(); float* U = (float*)(ws + WS_U); const float* GD = (const float*)(ws + WS_G);
      const int gt = bx * NTHREADS + tid;
      if (gt < NB * 4 * 4096) { const int bh = gt >> 12, e2 = (gt & 4095) * 2, d = e2 & 63; float s0 = 0.f, s1 = 0.f;
#pragma unroll 4
          for (int n = 0; n < 64; ++n) { const int item = bh * 64 + n; float* up = U + (size_t)item * 8192 + e2;
              const float u0 = up[0], u1 = up[1], g0 = GD[item * 64 + d], g1 = GD[item * 64 + d + 1];
              up[0] = s0; up[1] = s1; s0 = g0 * s0 + u0; s1 = g1 * s1 + u1; } } }
    grid.sync();
    { PHASE_BEGIN();
      for (int it = bx; it < NB * 4 * 64; it += G) gla_g3_item(lds, (const bf16*)(ws + WS_P), (const float*)(ws + WS_PM), ap->in[2], ap->in[3], ap->in[4], (const float*)(ws + WS_U), (bf16*)(ws + WS_O), it, tid); }
    grid.sync();
    { PHASE_BEGIN();
      float* scr = (float*)(ws + (bx < 128 ? WS_XB : WS_U)) + ((size_t)(bx & 127) * 8 + wave) * 16384;
      for (int pi = bx; pi < NB * 32; pi += G) { const int b = pi >> 5, c1 = pi & 31;
          dsa_item(lds, (const bf16*)(ws + WS_P), (const float*)(ws + WS_PM), (bf16*)(ws + WS_O), scr, b, 63 - c1, tid);
          dsa_item(lds, (const bf16*)(ws + WS_P), (const float*)(ws + WS_PM), (bf16*)(ws + WS_O), scr, b, c1, tid); } }
    grid.sync();
    { PHASE_BEGIN(); pg8::Gemm g{(bf16*)(ws + WS_O), (bf16*)(ws + WS_WOUT), M, D, D}; pg8::StaticOrder S; S.init(M, D, G, bx); pg8::EpiResF32 E{ap->out, (float*)(ws + WS_Y), D, ALPHA, 1.0f};
      pg8::gemm_phase<pg8::EpiResF32, pg8::StaticOrder, true, true>(lds, g, S, E); }
    grid.sync();
    { PHASE_BEGIN(); ln_rows((const float*)(ws + WS_Y), ap->in[12], ap->in[13], ap->out, (bf16*)(ws + WS_XB), gw, NGW, lane); }
    grid.sync();
    { PHASE_BEGIN(); pg8::Gemm g{(bf16*)(ws + WS_XB), (bf16*)(ws + WS_W2GU), M, 2 * FF, D}; pg8::StaticOrder S; S.init(M, 2 * FF, G, bx); pg8::EpiSwiglu E{(bf16*)(ws + WS_H), FF};
      pg8::gemm_phase<pg8::EpiSwiglu, pg8::StaticOrder, true, true>(lds, g, S, E); }
    grid.sync();
    { PHASE_BEGIN(); pg8::Gemm g{(bf16*)(ws + WS_H), (bf16*)(ws + WS_W2D), M, D, FF}; pg8::StaticOrder S; S.init(M, D, G, bx); pg8::EpiResF32 E{ap->out, (float*)(ws + WS_Y), D, ALPHA, 0.5f};
      pg8::gemm_phase<pg8::EpiResF32, pg8::StaticOrder, true, true>(lds, g, S, E); }
    grid.sync();
    { PHASE_BEGIN(); ln_rows((const float*)(ws + WS_Y), ap->in[14], ap->in[15], ap->out, (bf16*)nullptr, gw, NGW, lane); }
}

extern "C" void kernel_launch(void* const* d_in, const int* in_sizes, int n_in, void* d_out, int out_size, void* d_ws, size_t ws_size, hipStream_t stream) {
    static int grid = 0;
    if (grid == 0) {
        if (n_in != 16 || in_sizes[0] != M * D || out_size != M * D || ws_size < WS_END) { fprintf(stderr, "kernel_launch: unexpected shapes (n_in %d, in0 %d, out %d, ws %zu)\n", n_in, n_in > 0 ? in_sizes[0] : -1, out_size, ws_size); grid = -1; return; }
        int dev = 0, cus = 0, per_cu = 0;
        hipGetDevice(&dev); hipDeviceGetAttribute(&cus, hipDeviceAttributeMultiprocessorCount, dev);
        if (hipFuncSetAttribute((const void*)hymba_fwd, hipFuncAttributeMaxDynamicSharedMemorySize, LDS_BYTES) != hipSuccess) { fprintf(stderr, "kernel_launch: hipFuncSetAttribute failed\n"); grid = -1; return; }
        if (hipOccupancyMaxActiveBlocksPerMultiprocessor(&per_cu, (const void*)hymba_fwd, NTHREADS, LDS_BYTES) != hipSuccess || per_cu < 1) { fprintf(stderr, "kernel_launch: occupancy query says %d blocks per CU\n", per_cu); per_cu = 1; }
        (void)hipGetLastError();
        grid = cus;
    }
    if (grid < 0) return;
    Args a{};
    for (int i = 0; i < 16; ++i) a.in[i] = (const float*)d_in[i];
    a.out = (float*)d_out; a.ws = (unsigned char*)d_ws;
    void* kargs[] = {&a};
    hipError_t e = hipLaunchCooperativeKernel((const void*)hymba_fwd, dim3(grid), dim3(NTHREADS), kargs, LDS_BYTES, stream);
    if (e != hipSuccess) fprintf(stderr, "kernel_launch: cooperative launch failed: %s (grid %d)\n", hipGetErrorString(e), grid);
}
```

```cpp
#include <hip/hip_runtime.h>
#include <hip/hip_cooperative_groups.h>
#include <cstdio>
#include <cstdint>
namespace cg = cooperative_groups;
namespace pg8 {
#define PG8_LAS __attribute__((address_space(3)))
typedef unsigned short bf16_t;
typedef short bf16x8 __attribute__((ext_vector_type(8)));
typedef float f32x4 __attribute__((ext_vector_type(4)));
typedef unsigned u32x4 __attribute__((ext_vector_type(4)));
constexpr int BM = 256, BK = 64, HALF = 128, HTB = HALF * BK * 2  , STAGE_BYTES = 8 * HTB, NXCD = 8, WGM = 8;

__host__ __device__ __forceinline__ int lds_byte(int r, int c) { const int st = (r >> 4) * 2 + (c >> 5), rr = r & 15, cc = c & 31, ob = rr * 64 + cc * 2; return st * 1024 + (ob ^ (((ob >> 9) & 1) << 5)); }
__host__ __device__ __forceinline__ void stage_rc(int b, int& R, int& C) { const int st = b / 1024, sb = b % 1024, swz = sb ^ (((sb >> 9) & 1) << 5); R = (st >> 1) * 16 + swz / 64; C = (st & 1) * 32 + (swz % 64) / 2; }
__host__ __device__ __forceinline__ int perm32(int rho) { const int n = rho >> 4, i = rho & 15; return 8 * (i >> 2) + 4 * n + (i & 3); }

struct Unit { int pm, pn; };
struct Gemm { const bf16_t* A; const bf16_t* Bt; int M, N, K; };

struct StaticOrder {
    int nM, nN, nwg, G, c;
    __host__ __device__ void init(int M, int N, int G_, int c_) { nM = M / BM; nN = N / BM; nwg = nM * nN; G = G_; c = c_; }
    __host__ __device__ bool next(int i, Unit& u) const {
        const long L = (long)i * G + c; if (L >= nwg) return false;
        int wgid = (int)L; { const int q = nwg / NXCD, r = nwg % NXCD, xcd = wgid % NXCD, off = wgid / NXCD; wgid = (xcd < r ? xcd * (q + 1) : r * (q + 1) + (xcd - r) * q) + off; }
        const int nig = WGM * nN, gid = wgid / nig, fm = gid * WGM, gsz = (nM - fm) < WGM ? (nM - fm) : WGM;
        u.pm = fm + ((wgid % nig) % gsz); u.pn = (wgid % nig) / gsz; return true;
    }
    __device__ __forceinline__ void a_ready(const Unit&) const {}
    __device__ __forceinline__ void done(const Unit&) const {}
};

__device__ __forceinline__ unsigned cvt_pk_bf16(float lo, float hi) { unsigned r; asm volatile("v_cvt_pk_bf16_f32 %0, %1, %2" : "=v"(r) : "v"(lo), "v"(hi)); return r; }
typedef float f32x2 __attribute__((ext_vector_type(2)));
__device__ __forceinline__ float silu_f(float g) { return g * __builtin_amdgcn_rcpf(1.0f + __expf(-g)); }
struct EpiSwiglu {
    static constexpr bool PERM = true, AFTER_DRAIN = false;
    bf16_t* O; int ldc;
    __device__ __forceinline__ void operator()(const f32x4 (&acc)[2][2][4][2], const Unit& u, int wr, int wc, int fr, int fq) const {
        asm volatile("" : "+v"(fr), "+v"(fq));
        const int row0 = u.pm * BM + wr * 64 + fr, col0 = u.pn * HALF + wc * 32 + 8 * fq;
#pragma unroll
        for (int ai = 0; ai < 2; ++ai)
#pragma unroll
            for (int m = 0; m < 4; ++m) { bf16_t* rowp = O + (size_t)(row0 + ai * HALF + m * 16) * ldc + col0;
                const f32x4 g0 = acc[ai][0][m][0], g1 = acc[ai][0][m][1], u0 = acc[ai][1][m][0], u1 = acc[ai][1][m][1];
                u32x4 w; w.x = cvt_pk_bf16(silu_f(g0[0]) * u0[0], silu_f(g0[1]) * u0[1]); w.y = cvt_pk_bf16(silu_f(g0[2]) * u0[2], silu_f(g0[3]) * u0[3]);
                w.z = cvt_pk_bf16(silu_f(g1[0]) * u1[0], silu_f(g1[1]) * u1[1]); w.w = cvt_pk_bf16(silu_f(g1[2]) * u1[2], silu_f(g1[3]) * u1[3]);
                *(u32x4*)rowp = w; }
    }
};
struct EpiResF32 {
    static constexpr bool PERM = false, AFTER_DRAIN = false;
    const float* R; float* Y; int ldc; float alpha, scale;
    __device__ __forceinline__ void operator()(const f32x4 (&acc)[2][2][4][2], const Unit& u, int wr, int wc, int fr, int fq) const {
        asm volatile("" : "+v"(fr), "+v"(fq));
        const int col0 = u.pn * BM + wc * 32 + 4 * fq;
#pragma unroll
        for (int ai = 0; ai < 2; ++ai)
#pragma unroll
            for (int m = 0; m < 4; ++m) { const size_t off = (size_t)(u.pm * BM + ai * HALF + wr * 64 + m * 16 + fr) * ldc + col0;
#pragma unroll
                for (int bj = 0; bj < 2; ++bj)
#pragma unroll
                    for (int n = 0; n < 2; ++n) { const f32x4 r = *(const f32x4*)(R + off + bj * HALF + n * 16);
                        *(f32x4*)(Y + off + bj * HALF + n * 16) = r * alpha + acc[ai][bj][m][n] * scale; } }
    }
};
struct EpiProj {
    static constexpr bool PERM = true, AFTER_DRAIN = false;
    bf16_t* O; int ldc; float* PM; int misc_pn;
    __device__ __forceinline__ void operator()(const f32x4 (&acc)[2][2][4][2], const Unit& u, int wr, int wc, int fr, int fq) const {
        asm volatile("" : "+v"(fr), "+v"(fq));
        const int row0 = u.pm * BM + wr * 64 + fr, col0 = u.pn * BM + wc * 32 + 8 * fq;
#pragma unroll
        for (int ai = 0; ai < 2; ++ai)
#pragma unroll
            for (int m = 0; m < 4; ++m) { const int row = row0 + ai * HALF + m * 16; bf16_t* rowp = O + (size_t)row * ldc + col0;
#pragma unroll
                for (int bj = 0; bj < 2; ++bj) { const f32x4 v0 = acc[ai][bj][m][0], v1 = acc[ai][bj][m][1];
                    u32x4 w; w.x = cvt_pk_bf16(v0[0], v0[1]); w.y = cvt_pk_bf16(v0[2], v0[3]); w.z = cvt_pk_bf16(v1[0], v1[1]); w.w = cvt_pk_bf16(v1[2], v1[3]);
                    *(u32x4*)(rowp + bj * HALF) = w; }
                if (u.pn == misc_pn) { float* pm = PM + (size_t)row * 128 + wc * 32 + 8 * fq; *(f32x4*)pm = acc[ai][0][m][0]; *(f32x4*)(pm + 4) = acc[ai][0][m][1]; } }
    }
};
template <class Epi, class Sched, bool ALIGN_EPI = false, bool SP2 = false>
__device__ __forceinline__ void gemm_phase(PG8_LAS unsigned char* lds, const Gemm g, const Sched& S, const Epi& E) {
    int tid_l = threadIdx.x; asm volatile("" : "+v"(tid_l)); const int tid = tid_l, wid = __builtin_amdgcn_readfirstlane(tid >> 6), lane = tid & 63, wr = wid >> 2, wc = wid & 3, fr = lane & 15, fq = lane >> 4;
    const int K = g.K, nt = K / BK;
    unsigned voffA[2], voffB[2];
#pragma unroll
    for (int i = 0; i < 2; ++i) { int R, C; stage_rc(tid * 16 + i * 8192, R, C); const int Rb = Epi::PERM ? ((R & ~31) + perm32(R & 31)) : R;
        voffA[i] = (unsigned)(R * K + C) * 2u; voffB[i] = (unsigned)(Rb * K + C) * 2u; }
    const size_t kstep = (size_t)(BK * 2);
    const size_t hstep = (size_t)HALF * K * 2;
    const size_t tstep = 2 * hstep;
    const unsigned ldsw = (unsigned)wid * 1024u;
    const int aoff = lds_byte(wr * 64 + fr, fq * 8), boff = lds_byte(wc * 32 + fr, fq * 8);
#define PG8_SA(b, h) (((b) * 2 + (h)) * HTB)
#define PG8_SB(b, h) ((4 + (b) * 2 + (h)) * HTB)
#define PG8_STAGE(bufoff, gbase, voff) do { _Pragma("unroll") for (int _i = 0; _i < 2; ++_i) \
        __builtin_amdgcn_global_load_lds((const unsigned*)((const char*)(gbase) + (voff)[_i]), (PG8_LAS unsigned*)(lds + (bufoff) + ldsw + _i * 8192), 16, 0, 0); } while (0)
#define PG8_LDA(dst, b, h) do { _Pragma("unroll") for (int m = 0; m < 4; ++m) _Pragma("unroll") for (int k = 0; k < 2; ++k) dst[m][k] = *(const PG8_LAS bf16x8*)(lds + PG8_SA(b, h) + aoff + m * 2048 + k * 1024); } while (0)
#define PG8_LDB(dst, b, h) do { _Pragma("unroll") for (int n = 0; n < 2; ++n) _Pragma("unroll") for (int k = 0; k < 2; ++k) dst[n][k] = *(const PG8_LAS bf16x8*)(lds + PG8_SB(b, h) + boff + n * 2048 + k * 1024); } while (0)
#define PG8_MMA(ai, bj, At, Bt) do { __builtin_amdgcn_s_setprio(1); _Pragma("unroll") for (int m = 0; m < 4; ++m) _Pragma("unroll") for (int n = 0; n < 2; ++n) _Pragma("unroll") for (int k = 0; k < 2; ++k) \
        acc[ai][bj][m][n] = __builtin_amdgcn_mfma_f32_16x16x32_bf16(Bt[n][k], At[m][k], acc[ai][bj][m][n], 0, 0, 0); __builtin_amdgcn_s_setprio(0); } while (0)
#define PG8_WAIT_V(n) asm volatile("s_waitcnt vmcnt(" #n ")" ::: "memory")
#define PG8_WAIT_L(n) asm volatile("s_waitcnt lgkmcnt(" #n ")" ::: "memory")
#define PG8_BAR __builtin_amdgcn_s_barrier()
#define PG8_SCHED __builtin_amdgcn_sched_barrier(0)
    Unit cur, nxt; int ui = 0;
    if (!S.next(0, cur)) return;
    f32x4 acc[2][2][4][2];
#pragma unroll
    for (int a = 0; a < 2; ++a)
#pragma unroll
        for (int b = 0; b < 2; ++b)
#pragma unroll
            for (int m = 0; m < 4; ++m)
#pragma unroll
                for (int n = 0; n < 2; ++n) acc[a][b][m][n] = (f32x4){0.f, 0.f, 0.f, 0.f};
    bf16x8 At[4][2], B0[2][2], B1[2][2];
    const char* cA = (const char*)g.A + (size_t)cur.pm * tstep; const char* cB = (const char*)g.Bt + (size_t)cur.pn * tstep;
    S.a_ready(cur);
    if constexpr (SP2) {
        PG8_STAGE(PG8_SB(0, 0), cB, voffB); PG8_STAGE(PG8_SB(0, 1), cB + hstep, voffB); PG8_STAGE(PG8_SA(0, 0), cA, voffA); PG8_STAGE(PG8_SA(0, 1), cA + hstep, voffA);
        if (wr == 1) PG8_BAR;
        PG8_WAIT_V(2); PG8_BAR;
        PG8_STAGE(PG8_SB(1, 0), cB + kstep, voffB); PG8_STAGE(PG8_SA(1, 0), cA + kstep, voffA); PG8_STAGE(PG8_SB(1, 1), cB + hstep + kstep, voffB);
        PG8_WAIT_V(6); PG8_BAR;
    } else {
        PG8_STAGE(PG8_SB(0, 0), cB, voffB); PG8_STAGE(PG8_SA(0, 0), cA, voffA); PG8_STAGE(PG8_SB(0, 1), cB + hstep, voffB); PG8_STAGE(PG8_SA(0, 1), cA + hstep, voffA);
        if (wr == 1) PG8_BAR;
        PG8_WAIT_V(4); PG8_BAR;
        PG8_STAGE(PG8_SB(1, 0), cB + kstep, voffB); PG8_STAGE(PG8_SA(1, 0), cA + kstep, voffA); PG8_STAGE(PG8_SB(1, 1), cB + hstep + kstep, voffB);
        PG8_WAIT_V(6); PG8_BAR;
    }
    for (;;) {
        const bool has_next = S.next(ui + 1, nxt);
        const char* nA = has_next ? (const char*)g.A + (size_t)nxt.pm * tstep : cA; const char* nB = has_next ? (const char*)g.Bt + (size_t)nxt.pn * tstep : cB;
        for (int t = 0; t < nt; t += 2) {
            const bool last = (t == nt - 2);
            const char* a1 = cA + (size_t)(t + 1) * kstep;
            const char* a2 = last ? nA : cA + (size_t)(t + 2) * kstep; const char* b2 = last ? nB : cB + (size_t)(t + 2) * kstep;
            const char* a3 = a2 + kstep; const char* b3 = b2 + kstep;
            if (last && has_next) S.a_ready(nxt);
            if constexpr (SP2) {
            PG8_LDB(B0, 0, 0); PG8_LDB(B1, 0, 1); PG8_SCHED; PG8_LDA(At, 0, 0); PG8_STAGE(PG8_SA(1, 1), a1 + hstep, voffA);
            PG8_WAIT_V(8); PG8_WAIT_L(0); PG8_BAR; PG8_MMA(0, 0, At, B0); PG8_MMA(0, 1, At, B1); PG8_BAR; PG8_SCHED;
            PG8_LDA(At, 0, 1); PG8_STAGE(PG8_SB(0, 0), b2, voffB); PG8_STAGE(PG8_SB(0, 1), b2 + hstep, voffB); PG8_STAGE(PG8_SA(0, 0), a2, voffA);
            PG8_WAIT_V(8); PG8_WAIT_L(0); PG8_BAR; PG8_MMA(1, 0, At, B0); PG8_MMA(1, 1, At, B1); PG8_BAR; PG8_SCHED;
            PG8_LDB(B0, 1, 0); PG8_LDB(B1, 1, 1); PG8_SCHED; PG8_LDA(At, 1, 0); PG8_STAGE(PG8_SA(0, 1), a2 + hstep, voffA);
            PG8_WAIT_V(8); PG8_WAIT_L(0); PG8_BAR; PG8_MMA(0, 0, At, B0); PG8_MMA(0, 1, At, B1); PG8_BAR; PG8_SCHED;
            PG8_LDA(At, 1, 1); PG8_STAGE(PG8_SB(1, 0), b3, voffB); PG8_STAGE(PG8_SB(1, 1), b3 + hstep, voffB); PG8_STAGE(PG8_SA(1, 0), a3, voffA);
            PG8_WAIT_V(8); PG8_WAIT_L(0); PG8_BAR; PG8_MMA(1, 0, At, B0); PG8_MMA(1, 1, At, B1); PG8_BAR; PG8_SCHED;
            } else {
            PG8_LDB(B0, 0, 0); PG8_SCHED; PG8_LDA(At, 0, 0); PG8_STAGE(PG8_SA(1, 1), a1 + hstep, voffA);
            PG8_WAIT_L(8); PG8_BAR; PG8_WAIT_L(0); PG8_MMA(0, 0, At, B0); PG8_BAR; PG8_SCHED;
            PG8_LDB(B1, 0, 1); PG8_STAGE(PG8_SB(0, 0), b2, voffB);
            PG8_BAR; PG8_WAIT_L(0); PG8_MMA(0, 1, At, B1); PG8_BAR;
            PG8_LDA(At, 0, 1); PG8_STAGE(PG8_SA(0, 0), a2, voffA);
            PG8_BAR; PG8_WAIT_L(0); PG8_MMA(1, 0, At, B0); PG8_BAR; PG8_SCHED;
            PG8_STAGE(PG8_SB(0, 1), b2 + hstep, voffB);
            PG8_WAIT_V(6); PG8_BAR; PG8_MMA(1, 1, At, B1); PG8_BAR;
            PG8_LDB(B0, 1, 0); PG8_SCHED; PG8_LDA(At, 1, 0); PG8_STAGE(PG8_SA(0, 1), a2 + hstep, voffA);
            PG8_WAIT_L(8); PG8_BAR; PG8_WAIT_L(0); PG8_MMA(0, 0, At, B0); PG8_BAR; PG8_SCHED;
            PG8_LDB(B1, 1, 1); PG8_STAGE(PG8_SB(1, 0), b3, voffB);
            PG8_BAR; PG8_WAIT_L(0); PG8_MMA(0, 1, At, B1); PG8_BAR;
            PG8_LDA(At, 1, 1); PG8_STAGE(PG8_SA(1, 0), a3, voffA);
            PG8_BAR; PG8_WAIT_L(0); PG8_MMA(1, 0, At, B0); PG8_BAR; PG8_SCHED;
            PG8_STAGE(PG8_SB(1, 1), b3 + hstep, voffB);
            PG8_WAIT_V(6); PG8_BAR; PG8_MMA(1, 1, At, B1); PG8_BAR;
            }
        }
        if constexpr (ALIGN_EPI) { if (wr == 0) PG8_BAR; }
        if constexpr (!Epi::AFTER_DRAIN) { E(acc, cur, wr, wc, fr, fq); S.done(cur); }
        if (!has_next) break;
#pragma unroll
        for (int a = 0; a < 2; ++a)
#pragma unroll
            for (int b = 0; b < 2; ++b)
#pragma unroll
                for (int m = 0; m < 4; ++m)
#pragma unroll
                    for (int n = 0; n < 2; ++n) acc[a][b][m][n] = (f32x4){0.f, 0.f, 0.f, 0.f};
        cur = nxt; cA = nA; cB = nB; ++ui;
        if constexpr (ALIGN_EPI) { if (wr == 1) PG8_BAR; }
    }
    PG8_WAIT_V(0);
    if constexpr (!ALIGN_EPI) { if (wr == 0) PG8_BAR; }
    PG8_BAR;
    if constexpr (Epi::AFTER_DRAIN) { E.fused(acc, cur, wr, wc, fr, fq, lds, wid, lane); S.done(cur); }
#undef PG8_SA
#undef PG8_SB
#undef PG8_STAGE
#undef PG8_LDA
#undef PG8_LDB
#undef PG8_MMA
#undef PG8_WAIT_V
#undef PG8_WAIT_L
#undef PG8_BAR
#undef PG8_SCHED
}
}
constexpr int NB = 8, T = 4096, D = 1024, M = NB * T, FF = 2816, NIN = 3840, IN_TOTAL = 3672;
constexpr int PC_GQ = 0, PC_GK = 256, PC_GV = 512, PC_GG = 1024, PC_DQ = 1536, PC_DK = 2048, PC_DV = 2560, PC_IQ = 3072, PC_IK = 3584, PC_GA = 3648, PC_IW = 3664;
constexpr float LN_EPS = 1e-5f, RMS_EPS = 1e-6f;
constexpr float ALPHA = 1.189207115002721f;
constexpr size_t MiB = 1u << 20;
constexpr size_t WS_W1GU = 2 * MiB, WS_W1D = 13 * MiB, WS_WIN = 19 * MiB, WS_WOUT = 27 * MiB, WS_W2GU = 29 * MiB, WS_W2D = 40 * MiB;
constexpr size_t WS_XB = 50 * MiB, WS_H = 114 * MiB, WS_Y = 290 * MiB, WS_P = 114 * MiB, WS_U = 354 * MiB, WS_O = 418 * MiB, WS_PM = 482 * MiB, WS_G = 498 * MiB, WS_END = 499 * MiB;
constexpr int LDS_BYTES = 147456;
constexpr int NTHREADS = 512;

#define LAS __attribute__((address_space(3)))
typedef unsigned short bf16;
typedef float f32x4 __attribute__((ext_vector_type(4)));
typedef float f32x16 __attribute__((ext_vector_type(16)));
typedef short bf16x8 __attribute__((ext_vector_type(8)));
typedef unsigned u32x4 __attribute__((ext_vector_type(4)));
typedef unsigned u32x2 __attribute__((ext_vector_type(2)));

__device__ __forceinline__ unsigned f2bf(float f) { unsigned u = __builtin_bit_cast(unsigned, f); return (u + 0x7fffu + ((u >> 16) & 1u)) >> 16; }
__device__ __forceinline__ unsigned pk2(float lo, float hi) { return f2bf(lo) | (f2bf(hi) << 16); }
__device__ __forceinline__ float bf2f(unsigned short b) { return __builtin_bit_cast(float, (unsigned)b << 16); }
__device__ __forceinline__ float bflo(unsigned w) { return __builtin_bit_cast(float, w << 16); }
__device__ __forceinline__ float bfhi(unsigned w) { return __builtin_bit_cast(float, w & 0xffff0000u); }
__device__ __forceinline__ float silu(float g) { return g * __builtin_amdgcn_rcpf(1.0f + __expf(-g)); }
__device__ __forceinline__ float wave_sum(float v) {
#pragma unroll
    for (int o = 1; o < 64; o <<= 1) v += __shfl_xor(v, o);
    return v;
}
#define MFMA32(a, b, c) __builtin_amdgcn_mfma_f32_32x32x16_bf16((a), (b), (c), 0, 0, 0)
__device__ __forceinline__ int perm64(int k) { return (k & 32) | (k & 16) | (((k >> 2) & 1) << 3) | (((k >> 3) & 1) << 2) | (k & 3); }

struct MapId { __device__ __forceinline__ int operator()(int n) const { return n; } };
struct MapGU { __device__ __forceinline__ int operator()(int n) const { const int pn = n >> 8, bj = (n >> 7) & 1, j = n & 127; return bj * FF + pn * 128 + j; } };
struct MapIn { __device__ __forceinline__ int operator()(int n) const {
    if (n < 1536) return n;
    if (n < 3584) return n + 16;
    if (n < 3648) return 3600 + (n - 3584);
    if (n < 3664) return 1536 + (n - 3648);
    if (n < 3672) return 3664 + (n - 3664);
    return -1; } };
template <class Map>
__device__ __forceinline__ void transpose_item(const float* W, int K, int N, int ND, bf16* WT, LAS float* scr, int item, int lane, Map map) {
    const int nblk = ND / 32, kb = item / nblk, nb = item % nblk, k0 = 64 * kb, n0 = 32 * nb;
    const int src = map(n0 + (lane & 31));
#pragma unroll 8
    for (int i = 0; i < 32; ++i) { const int kk = 2 * i + (lane >> 5); scr[kk * 33 + (lane & 31)] = src >= 0 ? W[(size_t)(k0 + kk) * N + src] : 0.f; }
    asm volatile("s_waitcnt lgkmcnt(0)" ::: "memory");
    const int c = lane & 7;
#pragma unroll
    for (int j = 0; j < 4; ++j) { const int n = (lane >> 3) + 8 * j; const LAS float* s = scr + (8 * c) * 33 + n;
        u32x4 o; o.x = pk2(s[0 * 33], s[1 * 33]); o.y = pk2(s[2 * 33], s[3 * 33]); o.z = pk2(s[4 * 33], s[5 * 33]); o.w = pk2(s[6 * 33], s[7 * 33]);
        *(u32x4*)(WT + (size_t)(n0 + n) * K + k0 + 8 * c) = o; }
    asm volatile("s_waitcnt lgkmcnt(0)" ::: "memory");
}

__device__ __forceinline__ void ln_rows(const float* Y, const float* g, const float* be, float* Xf, bf16* Xb, int gw, int NGW, int lane) {
    f32x4 gv[4], bv[4];
#pragma unroll
    for (int j = 0; j < 4; ++j) { gv[j] = ((const f32x4*)g)[64 * j + lane]; bv[j] = ((const f32x4*)be)[64 * j + lane]; }
    for (int m = gw; m < M; m += NGW) {
        const f32x4* xr = (const f32x4*)(Y + (size_t)m * D) + lane;
        f32x4 v[4]; float s = 0.f;
#pragma unroll
        for (int j = 0; j < 4; ++j) { v[j] = xr[64 * j]; s += (v[j].x + v[j].y) + (v[j].z + v[j].w); }
        const float mean = wave_sum(s) * (1.f / D); float s2 = 0.f;
#pragma unroll
        for (int j = 0; j < 4; ++j) { v[j] = v[j] - mean; s2 += (v[j].x * v[j].x + v[j].y * v[j].y) + (v[j].z * v[j].z + v[j].w * v[j].w); }
        const float rstd = 1.f / sqrtf(wave_sum(s2) * (1.f / D) + LN_EPS);
#pragma unroll
        for (int j = 0; j < 4; ++j) { const f32x4 o = v[j] * rstd * gv[j] + bv[j];
            if (Xf) ((f32x4*)(Xf + (size_t)m * D))[64 * j + lane] = o;
            if (Xb) { u32x2 w; w.x = pk2(o.x, o.y); w.y = pk2(o.z, o.w); ((u32x2*)(Xb + (size_t)m * D))[64 * j + lane] = w; } }
    }
}

constexpr int GL_BL = 0, GL_SEGT = 16640, GL_QS = 18688, GL_KS = GL_QS + 9216, GL_VT = GL_KS + 9216, GL_ST = GL_VT + 18432, GL_RED = GL_ST + 18432, GL_END = GL_RED + 1024;
__device__ __forceinline__ void gla_b(LAS unsigned char* lds, const float* PM, const float* w2, const float* ba, int row0, int h, int tid) {
    LAS float* BL = (LAS float*)(lds + GL_BL); LAS float* SEGT = (LAS float*)(lds + GL_SEGT);
    const int d = tid & 63, seg = tid >> 6;
    float wcol[16];
#pragma unroll
    for (int r = 0; r < 16; ++r) wcol[r] = w2[r * 256 + h * 64 + d];
    const float bias = ba[h * 64 + d];
    float pre[8]; float run = 0.f;
#pragma unroll
    for (int t = 0; t < 8; ++t) { const float* ga = PM + (size_t)(row0 + seg * 8 + t) * 128 + 64; float z = bias;
#pragma unroll
        for (int r = 0; r < 16; ++r) z += ga[r] * wcol[r];
        const float ls = fminf(z, 0.f) - __logf(1.0f + __expf(-fabsf(z)));
        run += ls * (1.f / 16.f); pre[t] = run; }
    SEGT[seg * 64 + d] = run;
    __syncthreads();
    float off = 0.f;
#pragma unroll
    for (int s = 0; s < 8; ++s) off += (s < seg) ? SEGT[s * 64 + d] : 0.f;
#pragma unroll
    for (int t = 0; t < 8; ++t) BL[(seg * 8 + t) * 65 + d] = pre[t] + off;
    __syncthreads();
}
__device__ __forceinline__ void gla_stage_vt(LAS unsigned char* lds, const bf16* P, int row0, int h, int tid) {
    LAS bf16* VT = (LAS bf16*)(lds + GL_VT);
#pragma unroll
    for (int i = 0; i < 2; ++i) { const int piece = tid + i * NTHREADS, j = piece >> 4, c = piece & 15, pj = perm64(j);
        const u32x4 v = *(const u32x4*)(P + (size_t)(row0 + j) * NIN + PC_GV + h * 128 + c * 8);
        VT[(c * 8 + 0) * 72 + pj] = (bf16)(v.x & 0xffff); VT[(c * 8 + 1) * 72 + pj] = (bf16)(v.x >> 16);
        VT[(c * 8 + 2) * 72 + pj] = (bf16)(v.y & 0xffff); VT[(c * 8 + 3) * 72 + pj] = (bf16)(v.y >> 16);
        VT[(c * 8 + 4) * 72 + pj] = (bf16)(v.z & 0xffff); VT[(c * 8 + 5) * 72 + pj] = (bf16)(v.z >> 16);
        VT[(c * 8 + 6) * 72 + pj] = (bf16)(v.w & 0xffff); VT[(c * 8 + 7) * 72 + pj] = (bf16)(v.w >> 16); }
}
__device__ __forceinline__ void gla_g1_item(LAS unsigned char* lds, const bf16* P, const float* PM, const float* w2, const float* ba, float* U, float* G, int item, int tid) {
    const int bh = item >> 6, n = item & 63, b = bh >> 2, h = bh & 3, row0 = b * T + n * 64;
    const int lane = tid & 63, wave = tid >> 6, l32 = lane & 31, hi = lane >> 5;
    gla_b(lds, PM, w2, ba, row0, h, tid);
    LAS float* BL = (LAS float*)(lds + GL_BL); LAS bf16* KHT = (LAS bf16*)(lds + GL_QS); LAS bf16* VT = (LAS bf16*)(lds + GL_VT);
    { const int j = tid >> 3, dg = tid & 7, pj = perm64(j);
      const u32x4 kv = *(const u32x4*)(P + (size_t)(row0 + j) * NIN + PC_GK + h * 64 + dg * 8);
      const unsigned kw[4] = {kv.x, kv.y, kv.z, kv.w};
#pragma unroll
      for (int e = 0; e < 8; ++e) { const int d = dg * 8 + e; const float kf = (e & 1) ? bfhi(kw[e >> 1]) : bflo(kw[e >> 1]);
          KHT[d * 72 + pj] = (bf16)f2bf(kf * __expf(BL[63 * 65 + d] - BL[j * 65 + d])); } }
    gla_stage_vt(lds, P, row0, h, tid);
    __syncthreads();
    { const int dvt = wave & 3, dt = wave >> 2;
      f32x16 acc;
#pragma unroll
      for (int r = 0; r < 16; ++r) acc[r] = 0.f;
#pragma unroll
      for (int s = 0; s < 4; ++s) { const bf16x8 a = *(const LAS bf16x8*)(VT + (dvt * 32 + l32) * 72 + s * 16 + hi * 8); const bf16x8 bb = *(const LAS bf16x8*)(KHT + (dt * 32 + l32) * 72 + s * 16 + hi * 8);
          acc = MFMA32(a, bb, acc); }
#pragma unroll
      for (int r = 0; r < 16; ++r) { const int dv = dvt * 32 + 8 * (r >> 2) + 4 * hi + (r & 3); U[((size_t)item * 128 + dv) * 64 + dt * 32 + l32] = acc[r]; } }
    if (tid < 64) G[item * 64 + tid] = __expf(BL[63 * 65 + tid]);
    __syncthreads();
}
__device__ __forceinline__ void gla_g3_item(LAS unsigned char* lds, const bf16* P, const float* PM, const float* w2, const float* ba, const float* gnorm, const float* U, bf16* O, int item, int tid) {
    const int bh = item >> 6, n = item & 63, b = bh >> 2, h = bh & 3, row0 = b * T + n * 64;
    const int lane = tid & 63, wave = tid >> 6, l32 = lane & 31, hi = lane >> 5;
    gla_b(lds, PM, w2, ba, row0, h, tid);
    LAS float* BL = (LAS float*)(lds + GL_BL); LAS bf16* QS = (LAS bf16*)(lds + GL_QS); LAS bf16* KS = (LAS bf16*)(lds + GL_KS);
    LAS bf16* VT = (LAS bf16*)(lds + GL_VT); LAS bf16* ST = (LAS bf16*)(lds + GL_ST); LAS float* RED = (LAS float*)(lds + GL_RED);
    { const int i = tid >> 3, dg = tid & 7;
      const u32x4 qv = *(const u32x4*)(P + (size_t)(row0 + i) * NIN + PC_GQ + h * 64 + dg * 8);
      const u32x4 kv = *(const u32x4*)(P + (size_t)(row0 + i) * NIN + PC_GK + h * 64 + dg * 8);
      const unsigned qw[4] = {qv.x, qv.y, qv.z, qv.w}, kw[4] = {kv.x, kv.y, kv.z, kv.w};
      unsigned qo[4], ko[4];
#pragma unroll
      for (int e2 = 0; e2 < 4; ++e2) { const float b0 = BL[i * 65 + dg * 8 + 2 * e2], b1 = BL[i * 65 + dg * 8 + 2 * e2 + 1];
          qo[e2] = pk2(bflo(qw[e2]) * __expf(b0) * 0.125f, bfhi(qw[e2]) * __expf(b1) * 0.125f);
          ko[e2] = pk2(bflo(kw[e2]) * __expf(-b0), bfhi(kw[e2]) * __expf(-b1)); }
      *(LAS u32x4*)(QS + i * 72 + dg * 8) = (u32x4){qo[0], qo[1], qo[2], qo[3]};
      *(LAS u32x4*)(KS + i * 72 + dg * 8) = (u32x4){ko[0], ko[1], ko[2], ko[3]}; }
    gla_stage_vt(lds, P, row0, h, tid);
#pragma unroll
    for (int i = 0; i < 4; ++i) { const int idx4 = tid + i * NTHREADS, dv = idx4 >> 4, d4 = (idx4 & 15) * 4;
        const f32x4 s = *(const f32x4*)(U + ((size_t)item * 128 + dv) * 64 + d4);
        *(LAS u32x2*)(ST + dv * 72 + d4) = (u32x2){pk2(s.x, s.y), pk2(s.z, s.w)}; }
    __syncthreads();
    const int dvt = wave & 3, it = wave >> 2;
    f32x16 o;
    {
      bf16x8 qfr[4];
#pragma unroll
      for (int s = 0; s < 4; ++s) qfr[s] = *(const LAS bf16x8*)(QS + (it * 32 + l32) * 72 + s * 16 + hi * 8);
      bf16x8 pf[2][2];
#pragma unroll
      for (int jt = 0; jt < 2; ++jt) { f32x16 a;
#pragma unroll
          for (int r = 0; r < 16; ++r) a[r] = 0.f;
#pragma unroll
          for (int s = 0; s < 4; ++s) { const bf16x8 kf = *(const LAS bf16x8*)(KS + (jt * 32 + l32) * 72 + s * 16 + hi * 8); a = MFMA32(kf, qfr[s], a); }
          const int i = it * 32 + l32;
#pragma unroll
          for (int r = 0; r < 16; ++r) { const int j = jt * 32 + 8 * (r >> 2) + 4 * hi + (r & 3); a[r] = (j <= i) ? a[r] : 0.f; }
#pragma unroll
          for (int s2 = 0; s2 < 2; ++s2) { u32x4 w; w.x = pk2(a[8 * s2 + 0], a[8 * s2 + 1]); w.y = pk2(a[8 * s2 + 2], a[8 * s2 + 3]); w.z = pk2(a[8 * s2 + 4], a[8 * s2 + 5]); w.w = pk2(a[8 * s2 + 6], a[8 * s2 + 7]);
              pf[jt][s2] = __builtin_bit_cast(bf16x8, w); } }
#pragma unroll
      for (int r = 0; r < 16; ++r) o[r] = 0.f;
#pragma unroll
      for (int jt = 0; jt < 2; ++jt)
#pragma unroll
          for (int s2 = 0; s2 < 2; ++s2) { const bf16x8 vf = *(const LAS bf16x8*)(VT + (dvt * 32 + l32) * 72 + jt * 32 + s2 * 16 + hi * 8); o = MFMA32(vf, pf[jt][s2], o); }
#pragma unroll
      for (int s = 0; s < 4; ++s) { const bf16x8 sf = *(const LAS bf16x8*)(ST + (dvt * 32 + l32) * 72 + s * 16 + hi * 8); o = MFMA32(sf, qfr[s], o); }
    }
    float ss = 0.f;
#pragma unroll
    for (int r = 0; r < 16; ++r) ss += o[r] * o[r];
    ss += __shfl_xor(ss, 32);
    if (hi == 0) RED[dvt * 64 + it * 32 + l32] = ss;
    __syncthreads();
    { const int i = it * 32 + l32; const float tot = RED[i] + RED[64 + i] + RED[128 + i] + RED[192 + i];
      const float rs = 1.0f / sqrtf(tot * (1.f / 128.f) + RMS_EPS);
#pragma unroll
      for (int g = 0; g < 4; ++g) { const int dv0 = dvt * 32 + 8 * g + 4 * hi;
          const u32x2 gg = *(const u32x2*)(P + (size_t)(row0 + i) * NIN + PC_GG + h * 128 + dv0);
          const f32x4 gn = *(const f32x4*)(gnorm + dv0);
          const float o0 = o[4 * g + 0] * rs * gn.x * silu(bflo(gg.x)), o1 = o[4 * g + 1] * rs * gn.y * silu(bfhi(gg.x));
          const float o2 = o[4 * g + 2] * rs * gn.z * silu(bflo(gg.y)), o3 = o[4 * g + 3] * rs * gn.w * silu(bfhi(gg.y));
          *(u32x2*)(O + (size_t)(row0 + i) * D + h * 128 + dv0) = (u32x2){pk2(o0, o1), pk2(o2, o3)}; } }
    __syncthreads();
}
__device__ __forceinline__ void vt_item(LAS unsigned char* lds, bf16* P, int item, int tid) {
    const int row0 = item * 64;
    LAS bf16* LV = (LAS bf16*)lds;
#pragma unroll
    for (int i = 0; i < 8; ++i) { const int piece = tid + i * NTHREADS, key = piece >> 6, c16 = piece & 63;
        *(LAS u32x4*)(LV + key * 520 + c16 * 8) = *(const u32x4*)(P + (size_t)(row0 + key) * NIN + PC_DV + c16 * 8); }
    __syncthreads();
    const int col = tid; bf16* dst = P + (size_t)(row0 + (col >> 3)) * NIN + PC_DV + (col & 7) * 64;
#pragma unroll
    for (int pg = 0; pg < 8; ++pg) { unsigned e[8];
#pragma unroll
        for (int jj = 0; jj < 8; ++jj) { const int pos = pg * 8 + jj; const int key = (pos & 32) + (pos & 16) + 8 * (jj >> 2) + 4 * ((pos >> 3) & 1) + (jj & 3); e[jj] = LV[key * 520 + col]; }
        *(u32x4*)(dst + pg * 8) = (u32x4){e[0] | (e[1] << 16), e[2] | (e[3] << 16), e[4] | (e[5] << 16), e[6] | (e[7] << 16)}; }
    __syncthreads();
}

__device__ __forceinline__ unsigned okey(float x) { unsigned bits = __builtin_bit_cast(unsigned, x); if (bits == 0x80000000u) bits = 0u; return bits ^ ((unsigned)((int)bits >> 31) | 0x80000000u); }
__device__ __forceinline__ void dsa_item(LAS unsigned char* lds, const bf16* P, const float* PM, bf16* O, float* scr, int b, int c, int tid) {
    LAS unsigned* BMK = (LAS unsigned*)lds;
    const int lane = tid & 63, wave = __builtin_amdgcn_readfirstlane(tid >> 6), l32 = lane & 31, hi = lane >> 5;
    const int row0 = b * T + c * 64, nk64 = c + 1;
    const bf16* Kb = P + (size_t)(b * T) * NIN;
    for (int rt = 0; rt < 2; ++rt) {
        const int qbase = row0 + wave * 8 + rt * 4;
        {
            bf16x8 qf[4];
            { const int hh = l32 >> 2, q = l32 & 3; const bf16* qp = P + (size_t)(qbase + q) * NIN + PC_IQ + hh * 64 + hi * 8;
#pragma unroll
              for (int s = 0; s < 4; ++s) qf[s] = *(const bf16x8*)(qp + s * 16); }
            float w[4][4];
#pragma unroll
            for (int q = 0; q < 4; ++q)
#pragma unroll
                for (int g = 0; g < 4; ++g) w[q][g] = PM[(size_t)(qbase + q) * 128 + 80 + 2 * g + hi] * (0.125f * 0.35355339059327373f);
            const int ntile = 2 * nk64;
            bf16x8 kf[4];
            { const bf16* kp = Kb + (size_t)l32 * NIN + PC_IK + hi * 8;
#pragma unroll
              for (int s = 0; s < 4; ++s) kf[s] = *(const bf16x8*)(kp + s * 16); }
            for (int kt = 0; kt < ntile; ++kt) {
                bf16x8 kn[4];
                { const int ktn = (kt + 1 < ntile) ? kt + 1 : kt; const bf16* kp = Kb + (size_t)(ktn * 32 + l32) * NIN + PC_IK + hi * 8;
#pragma unroll
                  for (int s = 0; s < 4; ++s) kn[s] = *(const bf16x8*)(kp + s * 16); }
                f32x16 acc;
#pragma unroll
                for (int r = 0; r < 16; ++r) acc[r] = 0.f;
#pragma unroll
                for (int s = 0; s < 4; ++s) acc = MFMA32(qf[s], kf[s], acc);
                float part[4];
#pragma unroll
                for (int q = 0; q < 4; ++q) { float p = 0.f;
#pragma unroll
                    for (int g = 0; g < 4; ++g) p += w[q][g] * fmaxf(acc[4 * g + q], 0.f);
                    part[q] = p + __shfl_xor(p, 32); }
                const float a0 = hi ? part[2] : part[0], a1 = hi ? part[3] : part[1];
                scr[(2 * hi) * 4096 + kt * 32 + l32] = a0; scr[(2 * hi + 1) * 4096 + kt * 32 + l32] = a1;
#pragma unroll
                for (int s = 0; s < 4; ++s) kf[s] = kn[s];
            }
        }
        __builtin_amdgcn_fence(__ATOMIC_RELEASE, "workgroup"); asm volatile("s_waitcnt vmcnt(0)" ::: "memory");
        __builtin_amdgcn_fence(__ATOMIC_ACQUIRE, "workgroup");
        for (int q = 0; q < 4; ++q) {
            LAS unsigned* bmrow = BMK + (wave * 8 + rt * 4 + q) * 129;
            if (c < 4) {
                for (int j = 0; j <= c; ++j) if (lane < 2) bmrow[2 * j + lane] = 0xffffffffu;
            } else {
                unsigned kx[64];
#pragma unroll
                for (int g = 0; g < 4; ++g) {
                    if (g * 16 <= c) {
#pragma unroll
                        for (int jj = 0; jj < 16; ++jj) { const int j = g * 16 + jj; unsigned bits = __builtin_bit_cast(unsigned, scr[q * 4096 + j * 64 + lane]); if (bits == 0x80000000u) bits = 0u; kx[j] = (j <= c) ? bits : 0xff800000u; }
                    } else {
#pragma unroll
                        for (int jj = 0; jj < 16; ++jj) kx[g * 16 + jj] = 0xff800000u;
                    }
                }
                LAS unsigned* HIST = (LAS unsigned*)(lds + 33280 + wave * 6656); LAS unsigned* LIST = HIST + 1024; LAS unsigned* DENSE = LIST + 512;
#pragma unroll
                for (int i = 0; i < 4; ++i) *(LAS u32x4*)(HIST + i * 256 + lane * 4) = (u32x4){0u, 0u, 0u, 0u};
#pragma unroll
                for (int g = 0; g < 4; ++g) if (g * 16 <= c) {
#pragma unroll
                    for (int jj = 0; jj < 16; ++jj) { int bi = (int)__builtin_fmaf(__builtin_bit_cast(float, kx[g * 16 + jj]), 64.f, 512.f); bi = min(max(bi, 0), 1023);
                        __hip_atomic_fetch_add(HIST + bi, 1u, __ATOMIC_RELAXED, __HIP_MEMORY_SCOPE_WORKGROUP); }
                }
                int bstar, nb, cabove;
                { unsigned hs[16];
#pragma unroll
                  for (int i = 0; i < 4; ++i) { const u32x4 v = *(const LAS u32x4*)(HIST + lane * 16 + i * 4); hs[4 * i] = v.x; hs[4 * i + 1] = v.y; hs[4 * i + 2] = v.z; hs[4 * i + 3] = v.w; }
                  unsigned tl = 0;
#pragma unroll
                  for (int i = 0; i < 16; ++i) tl += hs[i];
                  unsigned incl = tl;
#pragma unroll
                  for (int o = 1; o < 64; o <<= 1) { const unsigned t = __shfl_down(incl, o); incl += (lane + o < 64) ? t : 0u; }
                  const unsigned above = incl - tl;
                  const unsigned long long own = __ballot(above < 256u && incl >= 256u);
                  unsigned cum = above; int lb = 0, lnb = 0, lca = 0; bool found = false;
#pragma unroll
                  for (int i = 15; i >= 0; --i) { const bool hit = !found && (cum + hs[i] >= 256u); lb = hit ? i : lb; lnb = hit ? (int)hs[i] : lnb; lca = hit ? (int)cum : lca; found = found || hit; cum += hs[i]; }
                  const int ol = own ? (int)__builtin_ctzll(own) : 0;
                  bstar = __shfl(lb, ol) + 16 * ol; nb = __shfl(lnb, ol); cabove = __shfl(lca, ol);
                  if (!own) bstar = 0; }
                bool fast = (bstar > 0) && (bstar < 1023) && (nb <= 64);
                unsigned thrbits = 0u; int n_ge = 0, need = 256 - cabove; unsigned ck = 0u, thr = 0u;
                if (fast) {
                    unsigned kt = 0;
#pragma unroll
                    for (int g = 0; g < 4; ++g) if (g * 16 <= c) {
#pragma unroll
                        for (int jj = 0; jj < 16; ++jj) { const unsigned v = kx[g * 16 + jj]; int bi = (int)__builtin_fmaf(__builtin_bit_cast(float, v), 64.f, 512.f); bi = min(max(bi, 0), 1023);
                            LIST[min(kt, 7u) * 64 + lane] = v; kt += (bi == bstar) ? 1u : 0u; }
                    }
                    if (__ballot(kt > 8u)) fast = false;
                    else {
                        unsigned incl = kt;
#pragma unroll
                        for (int o = 1; o < 64; o <<= 1) { const unsigned t = __shfl_up(incl, o); incl += (lane >= o) ? t : 0u; }
                        const unsigned off = incl - kt;
#pragma unroll
                        for (int i = 0; i < 8; ++i) if ((unsigned)i < kt) DENSE[off + i] = LIST[i * 64 + lane];
                        const unsigned cb = (lane < nb) ? DENSE[lane] : 0xff800000u;
                        ck = (lane < nb) ? (cb ^ ((unsigned)((int)cb >> 31) | 0x80000000u)) : 0u;
                        for (int bit = 31; bit >= 0; --bit) { const unsigned cand = thr | (1u << bit); if ((int)__popcll(__ballot(ck >= cand)) >= need) thr = cand; }
                        n_ge = (int)__popcll(__ballot(ck >= thr));
                        thrbits = (thr & 0x80000000u) ? (thr ^ 0x80000000u) : ~thr;
                    }
                }
                if (fast) {
                    const float thrf = __builtin_bit_cast(float, thrbits);
                    if (n_ge == need) {
#pragma unroll
                        for (int g = 0; g < 4; ++g) if (g * 16 <= c) {
#pragma unroll
                            for (int jj = 0; jj < 16; ++jj) { const int j = g * 16 + jj; const unsigned long long mm = __ballot(__builtin_bit_cast(float, kx[j]) >= thrf);
                                if (lane < 2) bmrow[2 * j + lane] = lane ? (unsigned)(mm >> 32) : (unsigned)mm; }
                        }
                    } else {
                        int need2 = need - (int)__popcll(__ballot(ck > thr));
#pragma unroll
                        for (int g = 0; g < 4; ++g) if (g * 16 <= c) {
#pragma unroll
                            for (int jj = 0; jj < 16; ++jj) { const int j = g * 16 + jj; const float xv = __builtin_bit_cast(float, kx[j]);
                                const unsigned long long gt = __ballot(xv > thrf); unsigned long long eq = __ballot(xv == thrf);
                                int ne = __popcll(eq);
                                while (ne > need2) { eq &= ~(1ull << (63 - __clzll((long long)eq))); --ne; }
                                need2 -= ne;
                                const unsigned long long mm = gt | eq;
                                if (lane < 2) bmrow[2 * j + lane] = lane ? (unsigned)(mm >> 32) : (unsigned)mm; }
                        }
                    }
                } else {
#pragma unroll
                    for (int j = 0; j < 64; ++j) { const unsigned b = kx[j]; kx[j] = (b == 0xff800000u) ? 0u : (b ^ ((unsigned)((int)b >> 31) | 0x80000000u)); }
                    unsigned cur = 0u;
                    for (int bit = 31; bit >= 0; --bit) {
                        const unsigned cand = cur | (1u << bit); int cnt = 0;
#pragma unroll
                        for (int g = 0; g < 4; ++g) if (g * 16 <= c) {
#pragma unroll
                            for (int jj = 0; jj < 16; ++jj) cnt += __popcll(__ballot(kx[g * 16 + jj] >= cand));
                        }
                        if (cnt >= 256) cur = cand;
                    }
                    int cgt = 0;
#pragma unroll
                    for (int g = 0; g < 4; ++g) if (g * 16 <= c) {
#pragma unroll
                        for (int jj = 0; jj < 16; ++jj) cgt += __popcll(__ballot(kx[g * 16 + jj] > cur));
                    }
                    int need3 = 256 - cgt;
#pragma unroll
                    for (int g = 0; g < 4; ++g) if (g * 16 <= c) {
#pragma unroll
                        for (int jj = 0; jj < 16; ++jj) { const int j = g * 16 + jj;
                            const unsigned long long gt = __ballot(kx[j] > cur); unsigned long long eq = __ballot(kx[j] == cur);
                            int ne = __popcll(eq);
                            while (ne > need3) { eq &= ~(1ull << (63 - __clzll((long long)eq))); --ne; }
                            need3 -= ne;
                            const unsigned long long mm = gt | eq;
                            if (lane < 2) bmrow[2 * j + lane] = lane ? (unsigned)(mm >> 32) : (unsigned)mm; }
                    }
                }
            }
        }
    }
    __syncthreads();
    {
        const int h = wave;
        LAS bf16* QL = (LAS bf16*)(lds + 33280 + wave * 9216);
        { const bf16* qp = P + (size_t)(row0 + lane) * NIN + PC_DQ + h * 64;
#pragma unroll
          for (int pc = 0; pc < 8; ++pc) *(LAS u32x4*)(QL + lane * 72 + pc * 8) = *(const u32x4*)(qp + pc * 8); }
        f32x16 oacc[2][2];
#pragma unroll
        for (int a = 0; a < 2; ++a)
#pragma unroll
            for (int bq = 0; bq < 2; ++bq)
#pragma unroll
                for (int r = 0; r < 16; ++r) oacc[a][bq][r] = 0.f;
        float lsum[2] = {0.f, 0.f};
        const float cs = 0.125f * 1.4426950408889634f;
        const int ntile = 2 * nk64;
        bf16x8 kf[4];
        { const bf16* kp = Kb + (size_t)l32 * NIN + PC_DK + h * 64 + hi * 8;
#pragma unroll
          for (int s = 0; s < 4; ++s) kf[s] = *(const bf16x8*)(kp + s * 16); }
        for (int kt = 0; kt < ntile; ++kt) {
            bf16x8 kn[4], vf[2][2];
#pragma unroll
            for (int dt = 0; dt < 2; ++dt) { const int col = h * 64 + dt * 32 + l32;
                const bf16* vp = Kb + (size_t)((kt >> 1) * 64 + (col >> 3)) * NIN + PC_DV + (col & 7) * 64 + (kt & 1) * 32 + hi * 8;
                vf[dt][0] = *(const bf16x8*)vp; vf[dt][1] = *(const bf16x8*)(vp + 16); }
            { const int ktn = (kt + 1 < ntile) ? kt + 1 : kt;
              const bf16* kp = Kb + (size_t)(ktn * 32 + l32) * NIN + PC_DK + h * 64 + hi * 8;
#pragma unroll
              for (int s = 0; s < 4; ++s) kn[s] = *(const bf16x8*)(kp + s * 16); }
#pragma unroll
            for (int qt = 0; qt < 2; ++qt) {
                f32x16 S;
#pragma unroll
                for (int r = 0; r < 16; ++r) S[r] = 0.f;
#pragma unroll
                for (int s = 0; s < 4; ++s) { const bf16x8 qfr = *(const LAS bf16x8*)(QL + (qt * 32 + l32) * 72 + s * 16 + hi * 8); S = MFMA32(kf[s], qfr, S); }
                const unsigned wsh = BMK[(qt * 32 + l32) * 129 + kt] >> (4 * hi);
                float p[16]; float ls = 0.f;
#pragma unroll
                for (int r = 0; r < 16; ++r) { const int bp = 8 * (r >> 2) + (r & 3); const float e = __builtin_amdgcn_exp2f(S[r] * cs);
                    const int mk = ((int)(wsh << (31 - bp))) >> 31; p[r] = __builtin_bit_cast(float, __builtin_bit_cast(int, e) & mk); ls += p[r]; }
                lsum[qt] += ls;
                bf16x8 pf[2];
#pragma unroll
                for (int s2 = 0; s2 < 2; ++s2) { u32x4 wv; wv.x = pg8::cvt_pk_bf16(p[8 * s2 + 0], p[8 * s2 + 1]); wv.y = pg8::cvt_pk_bf16(p[8 * s2 + 2], p[8 * s2 + 3]); wv.z = pg8::cvt_pk_bf16(p[8 * s2 + 4], p[8 * s2 + 5]); wv.w = pg8::cvt_pk_bf16(p[8 * s2 + 6], p[8 * s2 + 7]);
                    pf[s2] = __builtin_bit_cast(bf16x8, wv); }
#pragma unroll
                for (int dt = 0; dt < 2; ++dt)
#pragma unroll
                    for (int s2 = 0; s2 < 2; ++s2) oacc[dt][qt] = MFMA32(vf[dt][s2], pf[s2], oacc[dt][qt]);
            }
#pragma unroll
            for (int s = 0; s < 4; ++s) kf[s] = kn[s];
        }
#pragma unroll
        for (int qt = 0; qt < 2; ++qt) { const float tot = lsum[qt] + __shfl_xor(lsum[qt], 32); const float inv = 1.0f / tot;
            bf16* orow = O + (size_t)(row0 + qt * 32 + l32) * D + 512 + h * 64;
#pragma unroll
            for (int dt = 0; dt < 2; ++dt)
#pragma unroll
                for (int g = 0; g < 4; ++g) { const int d0 = dt * 32 + 8 * g + 4 * hi;
                    *(u32x2*)(orow + d0) = (u32x2){pk2(oacc[dt][qt][4 * g] * inv, oacc[dt][qt][4 * g + 1] * inv), pk2(oacc[dt][qt][4 * g + 2] * inv, oacc[dt][qt][4 * g + 3] * inv)}; } }
    }
    __syncthreads();
}

#define XB_TMO      128
#define XB_XCNT(j)  (256  + 64 * (j))
#define XB_XSUB(j)  (1280 + 64 * (j))
#define XB_XGEN(j)  (2304 + 64 * (j))
#define XB_TOP      3328
#define XB_TOPGEN   3392
#define XCD_BAR_WORDS 3456
#define XB_SPIN_CAP (1u << 18)

__device__ __forceinline__ unsigned xb_ld(unsigned* p)              { return __hip_atomic_load(p, __ATOMIC_RELAXED, __HIP_MEMORY_SCOPE_AGENT); }
__device__ __forceinline__ unsigned xb_add(unsigned* p, unsigned v) { return __hip_atomic_fetch_add(p, v, __ATOMIC_RELAXED, __HIP_MEMORY_SCOPE_AGENT); }
__device__ __forceinline__ unsigned xb_xcc_id() { return (unsigned)__builtin_amdgcn_s_getreg((3 << 11) | 20) & 0xFu; }
#define XB_SPIN(cond, bar) do { unsigned _sp = 0; while (cond) { __builtin_amdgcn_s_sleep(1); \
    if ((++_sp & 255u) == 0u) { if (xb_ld(&(bar)[XB_TMO])) break; if (_sp > XB_SPIN_CAP) { atomicAdd(&(bar)[XB_TMO], 1u); break; } } } } while (0)

struct XcdBarrier {
    unsigned* bar; unsigned x;
    volatile LAS unsigned* st;
};

__device__ __forceinline__ XcdBarrier xcd_barrier_post(unsigned* bar, volatile LAS unsigned* st) {
    XcdBarrier b; b.bar = bar; b.x = xb_xcc_id(); b.st = st;
    if (threadIdx.x == 0) (void)xb_add(&bar[XB_XCNT(b.x)], 1u);
    return b;
}
__device__ __forceinline__ void xcd_barrier_complete(unsigned* bar, unsigned x, unsigned& nloc, unsigned& nx) {
    const unsigned G = gridDim.x * gridDim.y * gridDim.z;
    unsigned sum, cnt, mine, sp = 0u;
    for (;;) {
        sum = 0u; cnt = 0u; mine = 0u;
#pragma unroll
        for (unsigned j = 0; j < 16; ++j) { const unsigned c = xb_ld(&bar[XB_XCNT(j)]); sum += c; cnt += (c > 0u) ? 1u : 0u; mine = (j == x) ? c : mine; }
        if (sum == G) break;
        __builtin_amdgcn_s_sleep(1);
        if ((++sp & 255u) == 0u) { if (xb_ld(&bar[XB_TMO])) break; if (sp > XB_SPIN_CAP) { atomicAdd(&bar[XB_TMO], 1u); break; } }
    }
    nloc = mine > 0u ? mine : 1u; nx = cnt > 0u ? cnt : 1u;
}

__device__ __forceinline__ void xcd_barrier(const XcdBarrier& b) {
    asm volatile("s_waitcnt vmcnt(0)" ::: "memory");
    __syncthreads();
    if (threadIdx.x == 0) {
        unsigned* bar = b.bar;
        __builtin_amdgcn_s_waitcnt(0);
        unsigned nloc = b.st[0], nx = b.st[1];
        if (nloc == 0u) { xcd_barrier_complete(bar, b.x, nloc, nx); b.st[0] = nloc; b.st[1] = nx; }
        const unsigned old = xb_add(&bar[XB_XSUB(b.x)], 1u);
        const unsigned gen = old / nloc;
        if (old + 1u == (gen + 1u) * nloc) {
            __builtin_amdgcn_fence(__ATOMIC_RELEASE, "agent");
            asm volatile("s_waitcnt vmcnt(0)" ::: "memory");
            const unsigned og = xb_add(&bar[XB_TOP], 1u);
            const unsigned tg = og / nx;
            if (og + 1u == (tg + 1u) * nx) xb_add(&bar[XB_TOPGEN], 1u);
            else XB_SPIN(xb_ld(&bar[XB_TOPGEN]) == tg, bar);
            __builtin_amdgcn_fence(__ATOMIC_ACQUIRE, "agent");
            xb_add(&bar[XB_XGEN(b.x)], 1u);
            asm volatile("s_waitcnt vmcnt(0)" ::: "memory");
        } else {
            XB_SPIN(xb_ld(&bar[XB_XGEN(b.x)]) == gen, bar);
            __builtin_amdgcn_fence(__ATOMIC_ACQUIRE, "agent");
            asm volatile("s_waitcnt vmcnt(0)" ::: "memory");
        }
    }
    __syncthreads();
}

struct Args { const float* in[16]; float* out; unsigned char* ws; };
#define PHASE_BEGIN() \
    const __attribute__((address_space(4))) Args* ap = (const __attribute__((address_space(4))) Args*)__builtin_amdgcn_kernarg_segment_ptr(); asm volatile("" : "+s"(ap)); \
    unsigned char* ws = ap->ws; int tid = threadIdx.x; asm volatile("" : "+v"(tid)); \
    const int lane = tid & 63, wave = __builtin_amdgcn_readfirstlane(tid >> 6); const int G = gridDim.x, bx = blockIdx.x; const int gw = bx * 8 + wave, NGW = G * 8; \
    (void)lane; (void)gw; (void)NGW; (void)ws
__global__ void __launch_bounds__(NTHREADS, 2) hymba_fwd(Args args) {
    extern __shared__ __attribute__((aligned(16))) unsigned char lds_raw[];
    LAS unsigned char* lds = (LAS unsigned char*)lds_raw;
    cg::grid_group grid = cg::this_grid();
    XcdBarrier xbar;
    { volatile LAS unsigned* MISC = (volatile LAS unsigned*)(lds + 131072 + 512);
      if (threadIdx.x < 64) MISC[threadIdx.x] = 0u;
      __syncthreads();
      const __attribute__((address_space(4))) Args* ap0 = (const __attribute__((address_space(4))) Args*)__builtin_amdgcn_kernarg_segment_ptr();
      xbar = xcd_barrier_post((unsigned*)ap0->ws, MISC + 8); }
    {
        PHASE_BEGIN();
        const float* x = ap->in[0]; const float* w_in = ap->in[1]; const float* w_out = ap->in[5];
        const float* f1gu = ap->in[6]; const float* f1d = ap->in[7]; const float* f2gu = ap->in[8]; const float* f2d = ap->in[9];
        bf16 *W1GU = (bf16*)(ws + WS_W1GU), *W1D = (bf16*)(ws + WS_W1D), *WIN = (bf16*)(ws + WS_WIN), *WOUT = (bf16*)(ws + WS_WOUT), *W2GU = (bf16*)(ws + WS_W2GU), *W2D = (bf16*)(ws + WS_W2D);
        bf16* XB = (bf16*)(ws + WS_XB);
        LAS float* scr = (LAS float*)(lds + wave * 16384);
        constexpr int I_GU = (D / 64) * (2 * FF / 32), I_D = (FF / 64) * (D / 32), I_IN = (D / 64) * (NIN / 32), I_OUT = (D / 64) * (D / 32);
        constexpr int NITEMS = 2 * I_GU + 2 * I_D + I_IN + I_OUT;
        for (int it = gw; it < NITEMS; it += NGW) {
            int r = it;
            if (r < I_GU) { transpose_item(f1gu, D, 2 * FF, 2 * FF, W1GU, scr, r, lane, MapGU()); continue; } r -= I_GU;
            if (r < I_GU) { transpose_item(f2gu, D, 2 * FF, 2 * FF, W2GU, scr, r, lane, MapGU()); continue; } r -= I_GU;
            if (r < I_D) { transpose_item(f1d, FF, D, D, W1D, scr, r, lane, MapId()); continue; } r -= I_D;
            if (r < I_D) { transpose_item(f2d, FF, D, D, W2D, scr, r, lane, MapId()); continue; } r -= I_D;
            if (r < I_IN) { transpose_item(w_in, D, IN_TOTAL, NIN, WIN, scr, r, lane, MapIn()); continue; } r -= I_IN;
            transpose_item(w_out, D, D, D, WOUT, scr, r, lane, MapId());
        }
        const size_t n8 = (size_t)M * D / 8;
        for (size_t i = (size_t)bx * NTHREADS + tid; i < n8; i += (size_t)G * NTHREADS) {
            const f32x4 a = ((const f32x4*)x)[2 * i], c = ((const f32x4*)x)[2 * i + 1];
            ((u32x4*)XB)[i] = (u32x4){pk2(a.x, a.y), pk2(a.z, a.w), pk2(c.x, c.y), pk2(c.z, c.w)};
        }
    }
    grid.sync();
    { PHASE_BEGIN(); pg8::Gemm g{(bf16*)(ws + WS_XB), (bf16*)(ws + WS_W1GU), M, 2 * FF, D}; pg8::StaticOrder S; S.init(M, 2 * FF, G, bx); pg8::EpiSwiglu E{(bf16*)(ws + WS_H), FF};
      pg8::gemm_phase<pg8::EpiSwiglu, pg8::StaticOrder, true, true>(lds, g, S, E); }
    xcd_barrier(xbar);
    { PHASE_BEGIN(); pg8::Gemm g{(bf16*)(ws + WS_H), (bf16*)(ws + WS_W1D), M, D, FF}; pg8::StaticOrder S; S.init(M, D, G, bx); pg8::EpiResF32 E{ap->in[0], (float*)(ws + WS_Y), D, ALPHA, 0.5f};
      pg8::gemm_phase<pg8::EpiResF32, pg8::StaticOrder, true, true>(lds, g, S, E); }
    xcd_barrier(xbar);
    { PHASE_BEGIN(); ln_rows((const float*)(ws + WS_Y), ap->in[10], ap->in[11], ap->out, (bf16*)(ws + WS_XB), gw, NGW, lane); }
    xcd_barrier(xbar);
    { PHASE_BEGIN(); pg8::Gemm g{(bf16*)(ws + WS_XB), (bf16*)(ws + WS_WIN), M, NIN, D}; pg8::StaticOrder S; S.init(M, NIN, G, bx); pg8::EpiProj E{(bf16*)(ws + WS_P), NIN, (float*)(ws + WS_PM), NIN / 256 - 1};
      pg8::gemm_phase<pg8::EpiProj, pg8::StaticOrder, true, true>(lds, g, S, E); }
    xcd_barrier(xbar);
    { PHASE_BEGIN();
      for (int it = bx; it < NB * 4 * 64; it += G) gla_g1_item(lds, (const bf16*)(ws + WS_P), (const float*)(ws + WS_PM), ap->in[2], ap->in[3], (float*)(ws + WS_U), (float*)(ws + WS_G), it, tid);
      for (int it = bx; it < NB * 64; it += G) vt_item(lds, (bf16*)(ws + WS_P), it, tid); }
    xcd_barrier(xbar);
    { PHASE_BEGIN(); float* U = (float*)(ws + WS_U); const float* GD = (const float*)(ws + WS_G);
      const int gt = bx * NTHREADS + tid;
      if (gt < NB * 4 * 4096) { const int bh = gt >> 12, e2 = (gt & 4095) * 2, d = e2 & 63; float s0 = 0.f, s1 = 0.f;
#pragma unroll 4
          for (int n = 0; n < 64; ++n) { const int item = bh * 64 + n; float* up = U + (size_t)item * 8192 + e2;
              const float u0 = up[0], u1 = up[1], g0 = GD[item * 64 + d], g1 = GD[item * 64 + d + 1];
              up[0] = s0; up[1] = s1; s0 = g0 * s0 + u0; s1 = g1 * s1 + u1; } } }
    xcd_barrier(xbar);
    { PHASE_BEGIN();
      for (int it = bx; it < NB * 4 * 64; it += G) gla_g3_item(lds, (const bf16*)(ws + WS_P), (const float*)(ws + WS_PM), ap->in[2], ap->in[3], ap->in[4], (const float*)(ws + WS_U), (bf16*)(ws + WS_O), it, tid); }
    xcd_barrier(xbar);
    { PHASE_BEGIN();
      float* scr = (float*)(ws + (bx < 128 ? WS_XB : WS_U)) + ((size_t)(bx & 127) * 8 + wave) * 16384;
      for (int pi = bx; pi < NB * 32; pi += G) { const int b = pi >> 5, c1 = pi & 31;
          dsa_item(lds, (const bf16*)(ws + WS_P), (const float*)(ws + WS_PM), (bf16*)(ws + WS_O), scr, b, 63 - c1, tid);
          dsa_item(lds, (const bf16*)(ws + WS_P), (const float*)(ws + WS_PM), (bf16*)(ws + WS_O), scr, b, c1, tid); } }
    xcd_barrier(xbar);
    { PHASE_BEGIN(); pg8::Gemm g{(bf16*)(ws + WS_O), (bf16*)(ws + WS_WOUT), M, D, D}; pg8::StaticOrder S; S.init(M, D, G, bx); pg8::EpiResF32 E{ap->out, (float*)(ws + WS_Y), D, ALPHA, 1.0f};
      pg8::gemm_phase<pg8::EpiResF32, pg8::StaticOrder, true, true>(lds, g, S, E); }
    xcd_barrier(xbar);
    { PHASE_BEGIN(); ln_rows((const float*)(ws + WS_Y), ap->in[12], ap->in[13], ap->out, (bf16*)(ws + WS_XB), gw, NGW, lane); }
    xcd_barrier(xbar);
    { PHASE_BEGIN(); pg8::Gemm g{(bf16*)(ws + WS_XB), (bf16*)(ws + WS_W2GU), M, 2 * FF, D}; pg8::StaticOrder S; S.init(M, 2 * FF, G, bx); pg8::EpiSwiglu E{(bf16*)(ws + WS_H), FF};
      pg8::gemm_phase<pg8::EpiSwiglu, pg8::StaticOrder, true, true>(lds, g, S, E); }
    xcd_barrier(xbar);
    { PHASE_BEGIN(); pg8::Gemm g{(bf16*)(ws + WS_H), (bf16*)(ws + WS_W2D), M, D, FF}; pg8::StaticOrder S; S.init(M, D, G, bx); pg8::EpiResF32 E{ap->out, (float*)(ws + WS_Y), D, ALPHA, 0.5f};
      pg8::gemm_phase<pg8::EpiResF32, pg8::StaticOrder, true, true>(lds, g, S, E); }
    xcd_barrier(xbar);
    { PHASE_BEGIN(); ln_rows((const float*)(ws + WS_Y), ap->in[14], ap->in[15], ap->out, (bf16*)nullptr, gw, NGW, lane); }
}

extern "C" void kernel_launch(void* const* d_in, const int* in_sizes, int n_in, void* d_out, int out_size, void* d_ws, size_t ws_size, hipStream_t stream) {
    static int grid = 0;
    if (grid == 0) {
        if (n_in != 16 || in_sizes[0] != M * D || out_size != M * D || ws_size < WS_END) { fprintf(stderr, "kernel_launch: unexpected shapes (n_in %d, in0 %d, out %d, ws %zu)\n", n_in, n_in > 0 ? in_sizes[0] : -1, out_size, ws_size); grid = -1; return; }
        int dev = 0, cus = 0, per_cu = 0;
        hipGetDevice(&dev); hipDeviceGetAttribute(&cus, hipDeviceAttributeMultiprocessorCount, dev);
        if (hipFuncSetAttribute((const void*)hymba_fwd, hipFuncAttributeMaxDynamicSharedMemorySize, LDS_BYTES) != hipSuccess) { fprintf(stderr, "kernel_launch: hipFuncSetAttribute failed\n"); grid = -1; return; }
        if (hipOccupancyMaxActiveBlocksPerMultiprocessor(&per_cu, (const void*)hymba_fwd, NTHREADS, LDS_BYTES) != hipSuccess || per_cu < 1) { fprintf(stderr, "kernel_launch: occupancy query says %d blocks per CU\n", per_cu); per_cu = 1; }
        (void)hipGetLastError();
        grid = cus;
    }
    if (grid < 0) return;
    if (hipMemsetAsync(d_ws, 0, 16384, stream) != hipSuccess) { fprintf(stderr, "kernel_launch: memset of the barrier words failed\n"); return; }
    Args a{};
    for (int i = 0; i < 16; ++i) a.in[i] = (const float*)d_in[i];
    a.out = (float*)d_out; a.ws = (unsigned char*)d_ws;
    void* kargs[] = {&a};
    hipError_t e = hipLaunchCooperativeKernel((const void*)hymba_fwd, dim3(grid), dim3(NTHREADS), kargs, LDS_BYTES, stream);
    if (e != hipSuccess) fprintf(stderr, "kernel_launch: cooperative launch failed: %s (grid %d)\n", hipGetErrorString(e), grid);
}
```

```cpp
#include <hip/hip_runtime.h>
#include <hip/hip_cooperative_groups.h>
#include <cstdio>
#include <cstdint>
namespace cg = cooperative_groups;
namespace pg8 {
#define PG8_LAS __attribute__((address_space(3)))
typedef unsigned short bf16_t;
typedef short bf16x8 __attribute__((ext_vector_type(8)));
typedef float f32x4 __attribute__((ext_vector_type(4)));
typedef unsigned u32x4 __attribute__((ext_vector_type(4)));
constexpr int BM = 256, BK = 64, HALF = 128, HTB = HALF * BK * 2  , STAGE_BYTES = 8 * HTB, NXCD = 8, WGM = 8;

__host__ __device__ __forceinline__ int lds_byte(int r, int c) { const int st = (r >> 4) * 2 + (c >> 5), rr = r & 15, cc = c & 31, ob = rr * 64 + cc * 2; return st * 1024 + (ob ^ (((ob >> 9) & 1) << 5)); }
__host__ __device__ __forceinline__ void stage_rc(int b, int& R, int& C) { const int st = b / 1024, sb = b % 1024, swz = sb ^ (((sb >> 9) & 1) << 5); R = (st >> 1) * 16 + swz / 64; C = (st & 1) * 32 + (swz % 64) / 2; }
__host__ __device__ __forceinline__ int perm32(int rho) { const int n = rho >> 4, i = rho & 15; return 8 * (i >> 2) + 4 * n + (i & 3); }

struct Unit { int pm, pn; };
struct Gemm { const bf16_t* A; const bf16_t* Bt; int M, N, K; };

struct StaticOrder {
    int nM, nN, nwg, G, c;
    __host__ __device__ void init(int M, int N, int G_, int c_) { nM = M / BM; nN = N / BM; nwg = nM * nN; G = G_; c = c_; }
    __host__ __device__ bool next(int i, Unit& u) const {
        const long L = (long)i * G + c; if (L >= nwg) return false;
        int wgid = (int)L; { const int q = nwg / NXCD, r = nwg % NXCD, xcd = wgid % NXCD, off = wgid / NXCD; wgid = (xcd < r ? xcd * (q + 1) : r * (q + 1) + (xcd - r) * q) + off; }
        const int nig = WGM * nN, gid = wgid / nig, fm = gid * WGM, gsz = (nM - fm) < WGM ? (nM - fm) : WGM;
        u.pm = fm + ((wgid % nig) % gsz); u.pn = (wgid % nig) / gsz; return true;
    }
    __device__ __forceinline__ void a_ready(const Unit&) const {}
    __device__ __forceinline__ void done(const Unit&) const {}
};

__device__ __forceinline__ unsigned cvt_pk_bf16(float lo, float hi) { unsigned r; asm volatile("v_cvt_pk_bf16_f32 %0, %1, %2" : "=v"(r) : "v"(lo), "v"(hi)); return r; }
typedef float f32x2 __attribute__((ext_vector_type(2)));
__device__ __forceinline__ float silu_f(float g) { return g * __builtin_amdgcn_rcpf(1.0f + __expf(-g)); }
struct EpiSwiglu {
    static constexpr bool PERM = true, AFTER_DRAIN = false;
    bf16_t* O; int ldc;
    __device__ __forceinline__ void operator()(const f32x4 (&acc)[2][2][4][2], const Unit& u, int wr, int wc, int fr, int fq) const {
        asm volatile("" : "+v"(fr), "+v"(fq));
        const int row0 = u.pm * BM + wr * 64 + fr, col0 = u.pn * HALF + wc * 32 + 8 * fq;
#pragma unroll
        for (int ai = 0; ai < 2; ++ai)
#pragma unroll
            for (int m = 0; m < 4; ++m) { bf16_t* rowp = O + (size_t)(row0 + ai * HALF + m * 16) * ldc + col0;
                const f32x4 g0 = acc[ai][0][m][0], g1 = acc[ai][0][m][1], u0 = acc[ai][1][m][0], u1 = acc[ai][1][m][1];
                u32x4 w; w.x = cvt_pk_bf16(silu_f(g0[0]) * u0[0], silu_f(g0[1]) * u0[1]); w.y = cvt_pk_bf16(silu_f(g0[2]) * u0[2], silu_f(g0[3]) * u0[3]);
                w.z = cvt_pk_bf16(silu_f(g1[0]) * u1[0], silu_f(g1[1]) * u1[1]); w.w = cvt_pk_bf16(silu_f(g1[2]) * u1[2], silu_f(g1[3]) * u1[3]);
                *(u32x4*)rowp = w; }
    }
};
struct EpiResF32 {
    static constexpr bool PERM = false, AFTER_DRAIN = false;
    const float* R; float* Y; int ldc; float alpha, scale;
    __device__ __forceinline__ void operator()(const f32x4 (&acc)[2][2][4][2], const Unit& u, int wr, int wc, int fr, int fq) const {
        asm volatile("" : "+v"(fr), "+v"(fq));
        const int col0 = u.pn * BM + wc * 32 + 4 * fq;
#pragma unroll
        for (int ai = 0; ai < 2; ++ai)
#pragma unroll
            for (int m = 0; m < 4; ++m) { const size_t off = (size_t)(u.pm * BM + ai * HALF + wr * 64 + m * 16 + fr) * ldc + col0;
#pragma unroll
                for (int bj = 0; bj < 2; ++bj)
#pragma unroll
                    for (int n = 0; n < 2; ++n) { const f32x4 r = *(const f32x4*)(R + off + bj * HALF + n * 16);
                        *(f32x4*)(Y + off + bj * HALF + n * 16) = r * alpha + acc[ai][bj][m][n] * scale; } }
    }
};
struct EpiProj {
    static constexpr bool PERM = true, AFTER_DRAIN = false;
    bf16_t* O; int ldc; float* PM; int misc_pn;
    __device__ __forceinline__ void operator()(const f32x4 (&acc)[2][2][4][2], const Unit& u, int wr, int wc, int fr, int fq) const {
        asm volatile("" : "+v"(fr), "+v"(fq));
        const int row0 = u.pm * BM + wr * 64 + fr, col0 = u.pn * BM + wc * 32 + 8 * fq;
#pragma unroll
        for (int ai = 0; ai < 2; ++ai)
#pragma unroll
            for (int m = 0; m < 4; ++m) { const int row = row0 + ai * HALF + m * 16; bf16_t* rowp = O + (size_t)row * ldc + col0;
#pragma unroll
                for (int bj = 0; bj < 2; ++bj) { const f32x4 v0 = acc[ai][bj][m][0], v1 = acc[ai][bj][m][1];
                    u32x4 w; w.x = cvt_pk_bf16(v0[0], v0[1]); w.y = cvt_pk_bf16(v0[2], v0[3]); w.z = cvt_pk_bf16(v1[0], v1[1]); w.w = cvt_pk_bf16(v1[2], v1[3]);
                    *(u32x4*)(rowp + bj * HALF) = w; }
                if (u.pn == misc_pn) { float* pm = PM + (size_t)row * 128 + wc * 32 + 8 * fq; *(f32x4*)pm = acc[ai][0][m][0]; *(f32x4*)(pm + 4) = acc[ai][0][m][1]; } }
    }
};
template <class Epi, class Sched, bool ALIGN_EPI = false, bool SP2 = false>
__device__ __forceinline__ void gemm_phase(PG8_LAS unsigned char* lds, const Gemm g, const Sched& S, const Epi& E) {
    int tid_l = threadIdx.x; asm volatile("" : "+v"(tid_l)); const int tid = tid_l, wid = __builtin_amdgcn_readfirstlane(tid >> 6), lane = tid & 63, wr = wid >> 2, wc = wid & 3, fr = lane & 15, fq = lane >> 4;
    const int K = g.K, nt = K / BK;
    unsigned voffA[2], voffB[2];
#pragma unroll
    for (int i = 0; i < 2; ++i) { int R, C; stage_rc(tid * 16 + i * 8192, R, C); const int Rb = Epi::PERM ? ((R & ~31) + perm32(R & 31)) : R;
        voffA[i] = (unsigned)(R * K + C) * 2u; voffB[i] = (unsigned)(Rb * K + C) * 2u; }
    const size_t kstep = (size_t)(BK * 2);
    const size_t hstep = (size_t)HALF * K * 2;
    const size_t tstep = 2 * hstep;
    const unsigned ldsw = (unsigned)wid * 1024u;
    const int aoff = lds_byte(wr * 64 + fr, fq * 8), boff = lds_byte(wc * 32 + fr, fq * 8);
#define PG8_SA(b, h) (((b) * 2 + (h)) * HTB)
#define PG8_SB(b, h) ((4 + (b) * 2 + (h)) * HTB)
#define PG8_STAGE(bufoff, gbase, voff) do { _Pragma("unroll") for (int _i = 0; _i < 2; ++_i) \
        __builtin_amdgcn_global_load_lds((const unsigned*)((const char*)(gbase) + (voff)[_i]), (PG8_LAS unsigned*)(lds + (bufoff) + ldsw + _i * 8192), 16, 0, 0); } while (0)
#define PG8_LDA(dst, b, h) do { _Pragma("unroll") for (int m = 0; m < 4; ++m) _Pragma("unroll") for (int k = 0; k < 2; ++k) dst[m][k] = *(const PG8_LAS bf16x8*)(lds + PG8_SA(b, h) + aoff + m * 2048 + k * 1024); } while (0)
#define PG8_LDB(dst, b, h) do { _Pragma("unroll") for (int n = 0; n < 2; ++n) _Pragma("unroll") for (int k = 0; k < 2; ++k) dst[n][k] = *(const PG8_LAS bf16x8*)(lds + PG8_SB(b, h) + boff + n * 2048 + k * 1024); } while (0)
#define PG8_MMA(ai, bj, At, Bt) do { __builtin_amdgcn_s_setprio(1); _Pragma("unroll") for (int m = 0; m < 4; ++m) _Pragma("unroll") for (int n = 0; n < 2; ++n) _Pragma("unroll") for (int k = 0; k < 2; ++k) \
        acc[ai][bj][m][n] = __builtin_amdgcn_mfma_f32_16x16x32_bf16(Bt[n][k], At[m][k], acc[ai][bj][m][n], 0, 0, 0); __builtin_amdgcn_s_setprio(0); } while (0)
#define PG8_WAIT_V(n) asm volatile("s_waitcnt vmcnt(" #n ")" ::: "memory")
#define PG8_WAIT_L(n) asm volatile("s_waitcnt lgkmcnt(" #n ")" ::: "memory")
#define PG8_BAR __builtin_amdgcn_s_barrier()
#define PG8_SCHED __builtin_amdgcn_sched_barrier(0)
    Unit cur, nxt; int ui = 0;
    if (!S.next(0, cur)) return;
    f32x4 acc[2][2][4][2];
#pragma unroll
    for (int a = 0; a < 2; ++a)
#pragma unroll
        for (int b = 0; b < 2; ++b)
#pragma unroll
            for (int m = 0; m < 4; ++m)
#pragma unroll
                for (int n = 0; n < 2; ++n) acc[a][b][m][n] = (f32x4){0.f, 0.f, 0.f, 0.f};
    bf16x8 At[4][2], B0[2][2], B1[2][2];
    const char* cA = (const char*)g.A + (size_t)cur.pm * tstep; const char* cB = (const char*)g.Bt + (size_t)cur.pn * tstep;
    S.a_ready(cur);
    if constexpr (SP2) {
        PG8_STAGE(PG8_SB(0, 0), cB, voffB); PG8_STAGE(PG8_SB(0, 1), cB + hstep, voffB); PG8_STAGE(PG8_SA(0, 0), cA, voffA); PG8_STAGE(PG8_SA(0, 1), cA + hstep, voffA);
        if (wr == 1) PG8_BAR;
        PG8_WAIT_V(2); PG8_BAR;
        PG8_STAGE(PG8_SB(1, 0), cB + kstep, voffB); PG8_STAGE(PG8_SA(1, 0), cA + kstep, voffA); PG8_STAGE(PG8_SB(1, 1), cB + hstep + kstep, voffB);
        PG8_WAIT_V(6); PG8_BAR;
    } else {
        PG8_STAGE(PG8_SB(0, 0), cB, voffB); PG8_STAGE(PG8_SA(0, 0), cA, voffA); PG8_STAGE(PG8_SB(0, 1), cB + hstep, voffB); PG8_STAGE(PG8_SA(0, 1), cA + hstep, voffA);
        if (wr == 1) PG8_BAR;
        PG8_WAIT_V(4); PG8_BAR;
        PG8_STAGE(PG8_SB(1, 0), cB + kstep, voffB); PG8_STAGE(PG8_SA(1, 0), cA + kstep, voffA); PG8_STAGE(PG8_SB(1, 1), cB + hstep + kstep, voffB);
        PG8_WAIT_V(6); PG8_BAR;
    }
    for (;;) {
        const bool has_next = S.next(ui + 1, nxt);
        const char* nA = has_next ? (const char*)g.A + (size_t)nxt.pm * tstep : cA; const char* nB = has_next ? (const char*)g.Bt + (size_t)nxt.pn * tstep : cB;
        for (int t = 0; t < nt; t += 2) {
            const bool last = (t == nt - 2);
            const char* a1 = cA + (size_t)(t + 1) * kstep;
            const char* a2 = last ? nA : cA + (size_t)(t + 2) * kstep; const char* b2 = last ? nB : cB + (size_t)(t + 2) * kstep;
            const char* a3 = a2 + kstep; const char* b3 = b2 + kstep;
            if (last && has_next) S.a_ready(nxt);
            if constexpr (SP2) {
            PG8_LDB(B0, 0, 0); PG8_LDB(B1, 0, 1); PG8_SCHED; PG8_LDA(At, 0, 0); PG8_STAGE(PG8_SA(1, 1), a1 + hstep, voffA);
            PG8_WAIT_V(8); PG8_WAIT_L(0); PG8_BAR; PG8_MMA(0, 0, At, B0); PG8_MMA(0, 1, At, B1); PG8_BAR; PG8_SCHED;
            PG8_LDA(At, 0, 1); PG8_STAGE(PG8_SB(0, 0), b2, voffB); PG8_STAGE(PG8_SB(0, 1), b2 + hstep, voffB); PG8_STAGE(PG8_SA(0, 0), a2, voffA);
            PG8_WAIT_V(8); PG8_WAIT_L(0); PG8_BAR; PG8_MMA(1, 0, At, B0); PG8_MMA(1, 1, At, B1); PG8_BAR; PG8_SCHED;
            PG8_LDB(B0, 1, 0); PG8_LDB(B1, 1, 1); PG8_SCHED; PG8_LDA(At, 1, 0); PG8_STAGE(PG8_SA(0, 1), a2 + hstep, voffA);
            PG8_WAIT_V(8); PG8_WAIT_L(0); PG8_BAR; PG8_MMA(0, 0, At, B0); PG8_MMA(0, 1, At, B1); PG8_BAR; PG8_SCHED;
            PG8_LDA(At, 1, 1); PG8_STAGE(PG8_SB(1, 0), b3, voffB); PG8_STAGE(PG8_SB(1, 1), b3 + hstep, voffB); PG8_STAGE(PG8_SA(1, 0), a3, voffA);
            PG8_WAIT_V(8); PG8_WAIT_L(0); PG8_BAR; PG8_MMA(1, 0, At, B0); PG8_MMA(1, 1, At, B1); PG8_BAR; PG8_SCHED;
            } else {
            PG8_LDB(B0, 0, 0); PG8_SCHED; PG8_LDA(At, 0, 0); PG8_STAGE(PG8_SA(1, 1), a1 + hstep, voffA);
            PG8_WAIT_L(8); PG8_BAR; PG8_WAIT_L(0); PG8_MMA(0, 0, At, B0); PG8_BAR; PG8_SCHED;
            PG8_LDB(B1, 0, 1); PG8_STAGE(PG8_SB(0, 0), b2, voffB);
            PG8_BAR; PG8_WAIT_L(0); PG8_MMA(0, 1, At, B1); PG8_BAR;
            PG8_LDA(At, 0, 1); PG8_STAGE(PG8_SA(0, 0), a2, voffA);
            PG8_BAR; PG8_WAIT_L(0); PG8_MMA(1, 0, At, B0); PG8_BAR; PG8_SCHED;
            PG8_STAGE(PG8_SB(0, 1), b2 + hstep, voffB);
            PG8_WAIT_V(6); PG8_BAR; PG8_MMA(1, 1, At, B1); PG8_BAR;
            PG8_LDB(B0, 1, 0); PG8_SCHED; PG8_LDA(At, 1, 0); PG8_STAGE(PG8_SA(0, 1), a2 + hstep, voffA);
            PG8_WAIT_L(8); PG8_BAR; PG8_WAIT_L(0); PG8_MMA(0, 0, At, B0); PG8_BAR; PG8_SCHED;
            PG8_LDB(B1, 1, 1); PG8_STAGE(PG8_SB(1, 0), b3, voffB);
            PG8_BAR; PG8_WAIT_L(0); PG8_MMA(0, 1, At, B1); PG8_BAR;
            PG8_LDA(At, 1, 1); PG8_STAGE(PG8_SA(1, 0), a3, voffA);
            PG8_BAR; PG8_WAIT_L(0); PG8_MMA(1, 0, At, B0); PG8_BAR; PG8_SCHED;
            PG8_STAGE(PG8_SB(1, 1), b3 + hstep, voffB);
            PG8_WAIT_V(6); PG8_BAR; PG8_MMA(1, 1, At, B1); PG8_BAR;
            }
        }
        if constexpr (ALIGN_EPI) { if (wr == 0) PG8_BAR; }
        if constexpr (!Epi::AFTER_DRAIN) { E(acc, cur, wr, wc, fr, fq); S.done(cur); }
        if (!has_next) break;
#pragma unroll
        for (int a = 0; a < 2; ++a)
#pragma unroll
            for (int b = 0; b < 2; ++b)
#pragma unroll
                for (int m = 0; m < 4; ++m)
#pragma unroll
                    for (int n = 0; n < 2; ++n) acc[a][b][m][n] = (f32x4){0.f, 0.f, 0.f, 0.f};
        cur = nxt; cA = nA; cB = nB; ++ui;
        if constexpr (ALIGN_EPI) { if (wr == 1) PG8_BAR; }
    }
    PG8_WAIT_V(0);
    if constexpr (!ALIGN_EPI) { if (wr == 0) PG8_BAR; }
    PG8_BAR;
    if constexpr (Epi::AFTER_DRAIN) { E.fused(acc, cur, wr, wc, fr, fq, lds, wid, lane); S.done(cur); }
#undef PG8_SA
#undef PG8_SB
#undef PG8_STAGE
#undef PG8_LDA
#undef PG8_LDB
#undef PG8_MMA
#undef PG8_WAIT_V
#undef PG8_WAIT_L
#undef PG8_BAR
#undef PG8_SCHED
}
}
constexpr int NB = 8, T = 4096, D = 1024, M = NB * T, FF = 2816, NIN = 3840, IN_TOTAL = 3672;
constexpr int PC_GQ = 0, PC_GK = 256, PC_GV = 512, PC_GG = 1024, PC_DQ = 1536, PC_DK = 2048, PC_DV = 2560, PC_IQ = 3072, PC_IK = 3584, PC_GA = 3648, PC_IW = 3664;
constexpr float LN_EPS = 1e-5f, RMS_EPS = 1e-6f;
constexpr float ALPHA = 1.189207115002721f;
constexpr size_t MiB = 1u << 20;
constexpr size_t WS_W1GU = 2 * MiB, WS_W1D = 13 * MiB, WS_WIN = 19 * MiB, WS_WOUT = 27 * MiB, WS_W2GU = 29 * MiB, WS_W2D = 40 * MiB;
constexpr size_t WS_XB = 50 * MiB, WS_H = 114 * MiB, WS_Y = 290 * MiB, WS_P = 114 * MiB, WS_U = 354 * MiB, WS_O = 418 * MiB, WS_PM = 482 * MiB, WS_G = 498 * MiB, WS_END = 499 * MiB;
constexpr int LDS_BYTES = 147456;
constexpr int NTHREADS = 512;

#define LAS __attribute__((address_space(3)))
typedef unsigned short bf16;
typedef float f32x4 __attribute__((ext_vector_type(4)));
typedef float f32x16 __attribute__((ext_vector_type(16)));
typedef short bf16x8 __attribute__((ext_vector_type(8)));
typedef unsigned u32x4 __attribute__((ext_vector_type(4)));
typedef unsigned u32x2 __attribute__((ext_vector_type(2)));

__device__ __forceinline__ unsigned f2bf(float f) { unsigned u = __builtin_bit_cast(unsigned, f); return (u + 0x7fffu + ((u >> 16) & 1u)) >> 16; }
__device__ __forceinline__ unsigned pk2(float lo, float hi) { return f2bf(lo) | (f2bf(hi) << 16); }
__device__ __forceinline__ float bf2f(unsigned short b) { return __builtin_bit_cast(float, (unsigned)b << 16); }
__device__ __forceinline__ float bflo(unsigned w) { return __builtin_bit_cast(float, w << 16); }
__device__ __forceinline__ float bfhi(unsigned w) { return __builtin_bit_cast(float, w & 0xffff0000u); }
__device__ __forceinline__ float silu(float g) { return g * __builtin_amdgcn_rcpf(1.0f + __expf(-g)); }
__device__ __forceinline__ float wave_sum(float v) {
#pragma unroll
    for (int o = 1; o < 64; o <<= 1) v += __shfl_xor(v, o);
    return v;
}
#define MFMA32(a, b, c) __builtin_amdgcn_mfma_f32_32x32x16_bf16((a), (b), (c), 0, 0, 0)
__device__ __forceinline__ int perm64(int k) { return (k & 32) | (k & 16) | (((k >> 2) & 1) << 3) | (((k >> 3) & 1) << 2) | (k & 3); }

struct MapId { __device__ __forceinline__ int operator()(int n) const { return n; } };
struct MapGU { __device__ __forceinline__ int operator()(int n) const { const int pn = n >> 8, bj = (n >> 7) & 1, j = n & 127; return bj * FF + pn * 128 + j; } };
struct MapIn { __device__ __forceinline__ int operator()(int n) const {
    if (n < 1536) return n;
    if (n < 3584) return n + 16;
    if (n < 3648) return 3600 + (n - 3584);
    if (n < 3664) return 1536 + (n - 3648);
    if (n < 3672) return 3664 + (n - 3664);
    return -1; } };
template <class Map>
__device__ __forceinline__ void transpose_item(const float* W, int K, int N, int ND, bf16* WT, LAS float* scr, int item, int lane, Map map) {
    const int nblk = ND / 32, kb = item / nblk, nb = item % nblk, k0 = 64 * kb, n0 = 32 * nb;
    const int src = map(n0 + (lane & 31));
#pragma unroll 8
    for (int i = 0; i < 32; ++i) { const int kk = 2 * i + (lane >> 5); scr[kk * 33 + (lane & 31)] = src >= 0 ? W[(size_t)(k0 + kk) * N + src] : 0.f; }
    asm volatile("s_waitcnt lgkmcnt(0)" ::: "memory");
    const int c = lane & 7;
#pragma unroll
    for (int j = 0; j < 4; ++j) { const int n = (lane >> 3) + 8 * j; const LAS float* s = scr + (8 * c) * 33 + n;
        u32x4 o; o.x = pk2(s[0 * 33], s[1 * 33]); o.y = pk2(s[2 * 33], s[3 * 33]); o.z = pk2(s[4 * 33], s[5 * 33]); o.w = pk2(s[6 * 33], s[7 * 33]);
        *(u32x4*)(WT + (size_t)(n0 + n) * K + k0 + 8 * c) = o; }
    asm volatile("s_waitcnt lgkmcnt(0)" ::: "memory");
}

__device__ __forceinline__ void ln_rows(const float* Y, const float* g, const float* be, float* Xf, bf16* Xb, int gw, int NGW, int lane) {
    f32x4 gv[4], bv[4];
#pragma unroll
    for (int j = 0; j < 4; ++j) { gv[j] = ((const f32x4*)g)[64 * j + lane]; bv[j] = ((const f32x4*)be)[64 * j + lane]; }
    for (int m = gw; m < M; m += NGW) {
        const f32x4* xr = (const f32x4*)(Y + (size_t)m * D) + lane;
        f32x4 v[4]; float s = 0.f;
#pragma unroll
        for (int j = 0; j < 4; ++j) { v[j] = xr[64 * j]; s += (v[j].x + v[j].y) + (v[j].z + v[j].w); }
        const float mean = wave_sum(s) * (1.f / D); float s2 = 0.f;
#pragma unroll
        for (int j = 0; j < 4; ++j) { v[j] = v[j] - mean; s2 += (v[j].x * v[j].x + v[j].y * v[j].y) + (v[j].z * v[j].z + v[j].w * v[j].w); }
        const float rstd = 1.f / sqrtf(wave_sum(s2) * (1.f / D) + LN_EPS);
#pragma unroll
        for (int j = 0; j < 4; ++j) { const f32x4 o = v[j] * rstd * gv[j] + bv[j];
            if (Xf) ((f32x4*)(Xf + (size_t)m * D))[64 * j + lane] = o;
            if (Xb) { u32x2 w; w.x = pk2(o.x, o.y); w.y = pk2(o.z, o.w); ((u32x2*)(Xb + (size_t)m * D))[64 * j + lane] = w; } }
    }
}

constexpr int GL_BL = 0, GL_SEGT = 16640, GL_QS = 18688, GL_KS = GL_QS + 9216, GL_VT = GL_KS + 9216, GL_ST = GL_VT + 18432, GL_RED = GL_ST + 18432, GL_END = GL_RED + 1024;
__device__ __forceinline__ void gla_b(LAS unsigned char* lds, const float* PM, const float* w2, const float* ba, int row0, int h, int tid) {
    LAS float* BL = (LAS float*)(lds + GL_BL); LAS float* SEGT = (LAS float*)(lds + GL_SEGT);
    const int d = tid & 63, seg = tid >> 6;
    float wcol[16];
#pragma unroll
    for (int r = 0; r < 16; ++r) wcol[r] = w2[r * 256 + h * 64 + d];
    const float bias = ba[h * 64 + d];
    float pre[8]; float run = 0.f;
#pragma unroll
    for (int t = 0; t < 8; ++t) { const float* ga = PM + (size_t)(row0 + seg * 8 + t) * 128 + 64; float z = bias;
#pragma unroll
        for (int r = 0; r < 16; ++r) z += ga[r] * wcol[r];
        const float ls = fminf(z, 0.f) - __logf(1.0f + __expf(-fabsf(z)));
        run += ls * (1.f / 16.f); pre[t] = run; }
    SEGT[seg * 64 + d] = run;
    __syncthreads();
    float off = 0.f;
#pragma unroll
    for (int s = 0; s < 8; ++s) off += (s < seg) ? SEGT[s * 64 + d] : 0.f;
#pragma unroll
    for (int t = 0; t < 8; ++t) BL[(seg * 8 + t) * 65 + d] = pre[t] + off;
    __syncthreads();
}
__device__ __forceinline__ void gla_stage_vt(LAS unsigned char* lds, const bf16* P, int row0, int h, int tid) {
    LAS bf16* VT = (LAS bf16*)(lds + GL_VT);
#pragma unroll
    for (int i = 0; i < 2; ++i) { const int piece = tid + i * NTHREADS, j = piece >> 4, c = piece & 15, pj = perm64(j);
        const u32x4 v = *(const u32x4*)(P + (size_t)(row0 + j) * NIN + PC_GV + h * 128 + c * 8);
        VT[(c * 8 + 0) * 72 + pj] = (bf16)(v.x & 0xffff); VT[(c * 8 + 1) * 72 + pj] = (bf16)(v.x >> 16);
        VT[(c * 8 + 2) * 72 + pj] = (bf16)(v.y & 0xffff); VT[(c * 8 + 3) * 72 + pj] = (bf16)(v.y >> 16);
        VT[(c * 8 + 4) * 72 + pj] = (bf16)(v.z & 0xffff); VT[(c * 8 + 5) * 72 + pj] = (bf16)(v.z >> 16);
        VT[(c * 8 + 6) * 72 + pj] = (bf16)(v.w & 0xffff); VT[(c * 8 + 7) * 72 + pj] = (bf16)(v.w >> 16); }
}
__device__ __forceinline__ void gla_g1_item(LAS unsigned char* lds, const bf16* P, const float* PM, const float* w2, const float* ba, float* U, float* G, int item, int tid) {
    const int bh = item >> 6, n = item & 63, b = bh >> 2, h = bh & 3, row0 = b * T + n * 64;
    const int lane = tid & 63, wave = tid >> 6, l32 = lane & 31, hi = lane >> 5;
    gla_b(lds, PM, w2, ba, row0, h, tid);
    LAS float* BL = (LAS float*)(lds + GL_BL); LAS bf16* KHT = (LAS bf16*)(lds + GL_QS); LAS bf16* VT = (LAS bf16*)(lds + GL_VT);
    { const int j = tid >> 3, dg = tid & 7, pj = perm64(j);
      const u32x4 kv = *(const u32x4*)(P + (size_t)(row0 + j) * NIN + PC_GK + h * 64 + dg * 8);
      const unsigned kw[4] = {kv.x, kv.y, kv.z, kv.w};
#pragma unroll
      for (int e = 0; e < 8; ++e) { const int d = dg * 8 + e; const float kf = (e & 1) ? bfhi(kw[e >> 1]) : bflo(kw[e >> 1]);
          KHT[d * 72 + pj] = (bf16)f2bf(kf * __expf(BL[63 * 65 + d] - BL[j * 65 + d])); } }
    gla_stage_vt(lds, P, row0, h, tid);
    __syncthreads();
    { const int dvt = wave & 3, dt = wave >> 2;
      f32x16 acc;
#pragma unroll
      for (int r = 0; r < 16; ++r) acc[r] = 0.f;
#pragma unroll
      for (int s = 0; s < 4; ++s) { const bf16x8 a = *(const LAS bf16x8*)(VT + (dvt * 32 + l32) * 72 + s * 16 + hi * 8); const bf16x8 bb = *(const LAS bf16x8*)(KHT + (dt * 32 + l32) * 72 + s * 16 + hi * 8);
          acc = MFMA32(a, bb, acc); }
#pragma unroll
      for (int r = 0; r < 16; ++r) { const int dv = dvt * 32 + 8 * (r >> 2) + 4 * hi + (r & 3); U[((size_t)item * 128 + dv) * 64 + dt * 32 + l32] = acc[r]; } }
    if (tid < 64) G[item * 64 + tid] = __expf(BL[63 * 65 + tid]);
    __syncthreads();
}
__device__ __forceinline__ void gla_g3_item(LAS unsigned char* lds, const bf16* P, const float* PM, const float* w2, const float* ba, const float* gnorm, const float* U, bf16* O, int item, int tid) {
    const int bh = item >> 6, n = item & 63, b = bh >> 2, h = bh & 3, row0 = b * T + n * 64;
    const int lane = tid & 63, wave = tid >> 6, l32 = lane & 31, hi = lane >> 5;
    gla_b(lds, PM, w2, ba, row0, h, tid);
    LAS float* BL = (LAS float*)(lds + GL_BL); LAS bf16* QS = (LAS bf16*)(lds + GL_QS); LAS bf16* KS = (LAS bf16*)(lds + GL_KS);
    LAS bf16* VT = (LAS bf16*)(lds + GL_VT); LAS bf16* ST = (LAS bf16*)(lds + GL_ST); LAS float* RED = (LAS float*)(lds + GL_RED);
    { const int i = tid >> 3, dg = tid & 7;
      const u32x4 qv = *(const u32x4*)(P + (size_t)(row0 + i) * NIN + PC_GQ + h * 64 + dg * 8);
      const u32x4 kv = *(const u32x4*)(P + (size_t)(row0 + i) * NIN + PC_GK + h * 64 + dg * 8);
      const unsigned qw[4] = {qv.x, qv.y, qv.z, qv.w}, kw[4] = {kv.x, kv.y, kv.z, kv.w};
      unsigned qo[4], ko[4];
#pragma unroll
      for (int e2 = 0; e2 < 4; ++e2) { const float b0 = BL[i * 65 + dg * 8 + 2 * e2], b1 = BL[i * 65 + dg * 8 + 2 * e2 + 1];
          qo[e2] = pk2(bflo(qw[e2]) * __expf(b0) * 0.125f, bfhi(qw[e2]) * __expf(b1) * 0.125f);
          ko[e2] = pk2(bflo(kw[e2]) * __expf(-b0), bfhi(kw[e2]) * __expf(-b1)); }
      *(LAS u32x4*)(QS + i * 72 + dg * 8) = (u32x4){qo[0], qo[1], qo[2], qo[3]};
      *(LAS u32x4*)(KS + i * 72 + dg * 8) = (u32x4){ko[0], ko[1], ko[2], ko[3]}; }
    gla_stage_vt(lds, P, row0, h, tid);
#pragma unroll
    for (int i = 0; i < 4; ++i) { const int idx4 = tid + i * NTHREADS, dv = idx4 >> 4, d4 = (idx4 & 15) * 4;
        const f32x4 s = *(const f32x4*)(U + ((size_t)item * 128 + dv) * 64 + d4);
        *(LAS u32x2*)(ST + dv * 72 + d4) = (u32x2){pk2(s.x, s.y), pk2(s.z, s.w)}; }
    __syncthreads();
    const int dvt = wave & 3, it = wave >> 2;
    f32x16 o;
    {
      bf16x8 qfr[4];
#pragma unroll
      for (int s = 0; s < 4; ++s) qfr[s] = *(const LAS bf16x8*)(QS + (it * 32 + l32) * 72 + s * 16 + hi * 8);
      bf16x8 pf[2][2];
#pragma unroll
      for (int jt = 0; jt < 2; ++jt) { f32x16 a;
#pragma unroll
          for (int r = 0; r < 16; ++r) a[r] = 0.f;
#pragma unroll
          for (int s = 0; s < 4; ++s) { const bf16x8 kf = *(const LAS bf16x8*)(KS + (jt * 32 + l32) * 72 + s * 16 + hi * 8); a = MFMA32(kf, qfr[s], a); }
          const int i = it * 32 + l32;
#pragma unroll
          for (int r = 0; r < 16; ++r) { const int j = jt * 32 + 8 * (r >> 2) + 4 * hi + (r & 3); a[r] = (j <= i) ? a[r] : 0.f; }
#pragma unroll
          for (int s2 = 0; s2 < 2; ++s2) { u32x4 w; w.x = pk2(a[8 * s2 + 0], a[8 * s2 + 1]); w.y = pk2(a[8 * s2 + 2], a[8 * s2 + 3]); w.z = pk2(a[8 * s2 + 4], a[8 * s2 + 5]); w.w = pk2(a[8 * s2 + 6], a[8 * s2 + 7]);
              pf[jt][s2] = __builtin_bit_cast(bf16x8, w); } }
#pragma unroll
      for (int r = 0; r < 16; ++r) o[r] = 0.f;
#pragma unroll
      for (int jt = 0; jt < 2; ++jt)
#pragma unroll
          for (int s2 = 0; s2 < 2; ++s2) { const bf16x8 vf = *(const LAS bf16x8*)(VT + (dvt * 32 + l32) * 72 + jt * 32 + s2 * 16 + hi * 8); o = MFMA32(vf, pf[jt][s2], o); }
#pragma unroll
      for (int s = 0; s < 4; ++s) { const bf16x8 sf = *(const LAS bf16x8*)(ST + (dvt * 32 + l32) * 72 + s * 16 + hi * 8); o = MFMA32(sf, qfr[s], o); }
    }
    float ss = 0.f;
#pragma unroll
    for (int r = 0; r < 16; ++r) ss += o[r] * o[r];
    ss += __shfl_xor(ss, 32);
    if (hi == 0) RED[dvt * 64 + it * 32 + l32] = ss;
    __syncthreads();
    { const int i = it * 32 + l32; const float tot = RED[i] + RED[64 + i] + RED[128 + i] + RED[192 + i];
      const float rs = 1.0f / sqrtf(tot * (1.f / 128.f) + RMS_EPS);
#pragma unroll
      for (int g = 0; g < 4; ++g) { const int dv0 = dvt * 32 + 8 * g + 4 * hi;
          const u32x2 gg = *(const u32x2*)(P + (size_t)(row0 + i) * NIN + PC_GG + h * 128 + dv0);
          const f32x4 gn = *(const f32x4*)(gnorm + dv0);
          const float o0 = o[4 * g + 0] * rs * gn.x * silu(bflo(gg.x)), o1 = o[4 * g + 1] * rs * gn.y * silu(bfhi(gg.x));
          const float o2 = o[4 * g + 2] * rs * gn.z * silu(bflo(gg.y)), o3 = o[4 * g + 3] * rs * gn.w * silu(bfhi(gg.y));
          *(u32x2*)(O + (size_t)(row0 + i) * D + h * 128 + dv0) = (u32x2){pk2(o0, o1), pk2(o2, o3)}; } }
    __syncthreads();
}
__device__ __forceinline__ void vt_item(LAS unsigned char* lds, bf16* P, int item, int tid) {
    const int row0 = item * 64;
    LAS bf16* LV = (LAS bf16*)lds;
#pragma unroll
    for (int i = 0; i < 8; ++i) { const int piece = tid + i * NTHREADS, key = piece >> 6, c16 = piece & 63;
        *(LAS u32x4*)(LV + key * 520 + c16 * 8) = *(const u32x4*)(P + (size_t)(row0 + key) * NIN + PC_DV + c16 * 8); }
    __syncthreads();
    const int col = tid; bf16* dst = P + (size_t)(row0 + (col >> 3)) * NIN + PC_DV + (col & 7) * 64;
#pragma unroll
    for (int pg = 0; pg < 8; ++pg) { unsigned e[8];
#pragma unroll
        for (int jj = 0; jj < 8; ++jj) { const int pos = pg * 8 + jj; const int key = (pos & 32) + (pos & 16) + 8 * (jj >> 2) + 4 * ((pos >> 3) & 1) + (jj & 3); e[jj] = LV[key * 520 + col]; }
        *(u32x4*)(dst + pg * 8) = (u32x4){e[0] | (e[1] << 16), e[2] | (e[3] << 16), e[4] | (e[5] << 16), e[6] | (e[7] << 16)}; }
    __syncthreads();
}

__device__ __forceinline__ unsigned okey(float x) { unsigned bits = __builtin_bit_cast(unsigned, x); if (bits == 0x80000000u) bits = 0u; return bits ^ ((unsigned)((int)bits >> 31) | 0x80000000u); }
__device__ __forceinline__ void dsa_item(LAS unsigned char* lds, const bf16* P, const float* PM, bf16* O, float* scr, int b, int c, int tid) {
    LAS unsigned* BMK = (LAS unsigned*)lds;
    const int lane = tid & 63, wave = __builtin_amdgcn_readfirstlane(tid >> 6), l32 = lane & 31, hi = lane >> 5;
    const int row0 = b * T + c * 64, nk64 = c + 1;
    const bf16* Kb = P + (size_t)(b * T) * NIN;
    for (int rt = 0; rt < 2; ++rt) {
        const int qbase = row0 + wave * 8 + rt * 4;
        {
            bf16x8 qf[4];
            { const int hh = l32 >> 2, q = l32 & 3; const bf16* qp = P + (size_t)(qbase + q) * NIN + PC_IQ + hh * 64 + hi * 8;
#pragma unroll
              for (int s = 0; s < 4; ++s) qf[s] = *(const bf16x8*)(qp + s * 16); }
            float w[4][4];
#pragma unroll
            for (int q = 0; q < 4; ++q)
#pragma unroll
                for (int g = 0; g < 4; ++g) w[q][g] = PM[(size_t)(qbase + q) * 128 + 80 + 2 * g + hi] * (0.125f * 0.35355339059327373f);
            LAS bf16* KI = (LAS bf16*)(lds + 33280);
            const int ldkey = tid >> 3, ldpart = tid & 7;
            const bf16* gsrc = Kb + (size_t)ldkey * NIN + PC_IK + ldpart * 8;
            u32x4 stg = *(const u32x4*)gsrc;
            *(LAS u32x4*)(KI + ldkey * 72 + ldpart * 8) = stg;
            __syncthreads();
            for (int kb = 0; kb < nk64; ++kb) {
                if (kb + 1 < nk64) stg = *(const u32x4*)(gsrc + (size_t)(kb + 1) * 64 * NIN);
                const LAS bf16* kbuf = KI + (kb & 1) * 4608;
#pragma unroll
                for (int sub = 0; sub < 2; ++sub) {
                    f32x16 acc;
#pragma unroll
                    for (int r = 0; r < 16; ++r) acc[r] = 0.f;
#pragma unroll
                    for (int s = 0; s < 4; ++s) { const bf16x8 kf = *(const LAS bf16x8*)(kbuf + (sub * 32 + l32) * 72 + s * 16 + hi * 8); acc = MFMA32(qf[s], kf, acc); }
                    float part[4];
#pragma unroll
                    for (int q = 0; q < 4; ++q) { float p = 0.f;
#pragma unroll
                        for (int g = 0; g < 4; ++g) p += w[q][g] * fmaxf(acc[4 * g + q], 0.f);
                        part[q] = p + __shfl_xor(p, 32); }
                    const float a0 = hi ? part[2] : part[0], a1 = hi ? part[3] : part[1];
                    scr[(2 * hi) * 4096 + kb * 64 + sub * 32 + l32] = a0; scr[(2 * hi + 1) * 4096 + kb * 64 + sub * 32 + l32] = a1;
                }
                if (kb + 1 < nk64) *(LAS u32x4*)(KI + ((kb + 1) & 1) * 4608 + ldkey * 72 + ldpart * 8) = stg;
                __syncthreads();
            }
        }
        __builtin_amdgcn_fence(__ATOMIC_RELEASE, "workgroup"); asm volatile("s_waitcnt vmcnt(0)" ::: "memory");
        __builtin_amdgcn_fence(__ATOMIC_ACQUIRE, "workgroup");
        for (int q = 0; q < 4; ++q) {
            LAS unsigned* bmrow = BMK + (wave * 8 + rt * 4 + q) * 129;
            if (c < 4) {
                for (int j = 0; j <= c; ++j) if (lane < 2) bmrow[2 * j + lane] = 0xffffffffu;
            } else {
                unsigned kx[64];
#pragma unroll
                for (int g = 0; g < 4; ++g) {
                    if (g * 16 <= c) {
#pragma unroll
                        for (int jj = 0; jj < 16; ++jj) { const int j = g * 16 + jj; unsigned bits = __builtin_bit_cast(unsigned, scr[q * 4096 + j * 64 + lane]); if (bits == 0x80000000u) bits = 0u; kx[j] = (j <= c) ? bits : 0xff800000u; }
                    } else {
#pragma unroll
                        for (int jj = 0; jj < 16; ++jj) kx[g * 16 + jj] = 0xff800000u;
                    }
                }
                LAS unsigned* HIST = (LAS unsigned*)(lds + 51712 + wave * 6656); LAS unsigned* LIST = HIST + 1024; LAS unsigned* DENSE = LIST + 512;
#pragma unroll
                for (int i = 0; i < 4; ++i) *(LAS u32x4*)(HIST + i * 256 + lane * 4) = (u32x4){0u, 0u, 0u, 0u};
#pragma unroll
                for (int g = 0; g < 4; ++g) if (g * 16 <= c) {
#pragma unroll
                    for (int jj = 0; jj < 16; ++jj) { int bi = (int)__builtin_fmaf(__builtin_bit_cast(float, kx[g * 16 + jj]), 64.f, 512.f); bi = min(max(bi, 0), 1023);
                        __hip_atomic_fetch_add(HIST + bi, 1u, __ATOMIC_RELAXED, __HIP_MEMORY_SCOPE_WORKGROUP); }
                }
                int bstar, nb, cabove;
                { unsigned hs[16];
#pragma unroll
                  for (int i = 0; i < 4; ++i) { const u32x4 v = *(const LAS u32x4*)(HIST + lane * 16 + i * 4); hs[4 * i] = v.x; hs[4 * i + 1] = v.y; hs[4 * i + 2] = v.z; hs[4 * i + 3] = v.w; }
                  unsigned tl = 0;
#pragma unroll
                  for (int i = 0; i < 16; ++i) tl += hs[i];
                  unsigned incl = tl;
#pragma unroll
                  for (int o = 1; o < 64; o <<= 1) { const unsigned t = __shfl_down(incl, o); incl += (lane + o < 64) ? t : 0u; }
                  const unsigned above = incl - tl;
                  const unsigned long long own = __ballot(above < 256u && incl >= 256u);
                  unsigned cum = above; int lb = 0, lnb = 0, lca = 0; bool found = false;
#pragma unroll
                  for (int i = 15; i >= 0; --i) { const bool hit = !found && (cum + hs[i] >= 256u); lb = hit ? i : lb; lnb = hit ? (int)hs[i] : lnb; lca = hit ? (int)cum : lca; found = found || hit; cum += hs[i]; }
                  const int ol = own ? (int)__builtin_ctzll(own) : 0;
                  bstar = __shfl(lb, ol) + 16 * ol; nb = __shfl(lnb, ol); cabove = __shfl(lca, ol);
                  if (!own) bstar = 0; }
                bool fast = (bstar > 0) && (bstar < 1023) && (nb <= 64);
                unsigned thrbits = 0u; int n_ge = 0, need = 256 - cabove; unsigned ck = 0u, thr = 0u;
                if (fast) {
                    unsigned kt = 0;
#pragma unroll
                    for (int g = 0; g < 4; ++g) if (g * 16 <= c) {
#pragma unroll
                        for (int jj = 0; jj < 16; ++jj) { const unsigned v = kx[g * 16 + jj]; int bi = (int)__builtin_fmaf(__builtin_bit_cast(float, v), 64.f, 512.f); bi = min(max(bi, 0), 1023);
                            LIST[min(kt, 7u) * 64 + lane] = v; kt += (bi == bstar) ? 1u : 0u; }
                    }
                    if (__ballot(kt > 8u)) fast = false;
                    else {
                        unsigned incl = kt;
#pragma unroll
                        for (int o = 1; o < 64; o <<= 1) { const unsigned t = __shfl_up(incl, o); incl += (lane >= o) ? t : 0u; }
                        const unsigned off = incl - kt;
#pragma unroll
                        for (int i = 0; i < 8; ++i) if ((unsigned)i < kt) DENSE[off + i] = LIST[i * 64 + lane];
                        const unsigned cb = (lane < nb) ? DENSE[lane] : 0xff800000u;
                        ck = (lane < nb) ? (cb ^ ((unsigned)((int)cb >> 31) | 0x80000000u)) : 0u;
                        for (int bit = 31; bit >= 0; --bit) { const unsigned cand = thr | (1u << bit); if ((int)__popcll(__ballot(ck >= cand)) >= need) thr = cand; }
                        n_ge = (int)__popcll(__ballot(ck >= thr));
                        thrbits = (thr & 0x80000000u) ? (thr ^ 0x80000000u) : ~thr;
                    }
                }
                if (fast) {
                    const float thrf = __builtin_bit_cast(float, thrbits);
                    if (n_ge == need) {
#pragma unroll
                        for (int g = 0; g < 4; ++g) if (g * 16 <= c) {
#pragma unroll
                            for (int jj = 0; jj < 16; ++jj) { const int j = g * 16 + jj; const unsigned long long mm = __ballot(__builtin_bit_cast(float, kx[j]) >= thrf);
                                if (lane < 2) bmrow[2 * j + lane] = lane ? (unsigned)(mm >> 32) : (unsigned)mm; }
                        }
                    } else {
                        int need2 = need - (int)__popcll(__ballot(ck > thr));
#pragma unroll
                        for (int g = 0; g < 4; ++g) if (g * 16 <= c) {
#pragma unroll
                            for (int jj = 0; jj < 16; ++jj) { const int j = g * 16 + jj; const float xv = __builtin_bit_cast(float, kx[j]);
                                const unsigned long long gt = __ballot(xv > thrf); unsigned long long eq = __ballot(xv == thrf);
                                int ne = __popcll(eq);
                                while (ne > need2) { eq &= ~(1ull << (63 - __clzll((long long)eq))); --ne; }
                                need2 -= ne;
                                const unsigned long long mm = gt | eq;
                                if (lane < 2) bmrow[2 * j + lane] = lane ? (unsigned)(mm >> 32) : (unsigned)mm; }
                        }
                    }
                } else {
#pragma unroll
                    for (int j = 0; j < 64; ++j) { const unsigned b = kx[j]; kx[j] = (b == 0xff800000u) ? 0u : (b ^ ((unsigned)((int)b >> 31) | 0x80000000u)); }
                    unsigned cur = 0u;
                    for (int bit = 31; bit >= 0; --bit) {
                        const unsigned cand = cur | (1u << bit); int cnt = 0;
#pragma unroll
                        for (int g = 0; g < 4; ++g) if (g * 16 <= c) {
#pragma unroll
                            for (int jj = 0; jj < 16; ++jj) cnt += __popcll(__ballot(kx[g * 16 + jj] >= cand));
                        }
                        if (cnt >= 256) cur = cand;
                    }
                    int cgt = 0;
#pragma unroll
                    for (int g = 0; g < 4; ++g) if (g * 16 <= c) {
#pragma unroll
                        for (int jj = 0; jj < 16; ++jj) cgt += __popcll(__ballot(kx[g * 16 + jj] > cur));
                    }
                    int need3 = 256 - cgt;
#pragma unroll
                    for (int g = 0; g < 4; ++g) if (g * 16 <= c) {
#pragma unroll
                        for (int jj = 0; jj < 16; ++jj) { const int j = g * 16 + jj;
                            const unsigned long long gt = __ballot(kx[j] > cur); unsigned long long eq = __ballot(kx[j] == cur);
                            int ne = __popcll(eq);
                            while (ne > need3) { eq &= ~(1ull << (63 - __clzll((long long)eq))); --ne; }
                            need3 -= ne;
                            const unsigned long long mm = gt | eq;
                            if (lane < 2) bmrow[2 * j + lane] = lane ? (unsigned)(mm >> 32) : (unsigned)mm; }
                    }
                }
            }
        }
    }
    __syncthreads();
    {
        const int h = wave;
        LAS bf16* QL = (LAS bf16*)(lds + 33280 + wave * 9216);
        { const bf16* qp = P + (size_t)(row0 + lane) * NIN + PC_DQ + h * 64;
#pragma unroll
          for (int pc = 0; pc < 8; ++pc) *(LAS u32x4*)(QL + lane * 72 + pc * 8) = *(const u32x4*)(qp + pc * 8); }
        f32x16 oacc[2][2];
#pragma unroll
        for (int a = 0; a < 2; ++a)
#pragma unroll
            for (int bq = 0; bq < 2; ++bq)
#pragma unroll
                for (int r = 0; r < 16; ++r) oacc[a][bq][r] = 0.f;
        float lsum[2] = {0.f, 0.f};
        const float cs = 0.125f * 1.4426950408889634f;
        const int ntile = 2 * nk64;
        bf16x8 kf[4];
        { const bf16* kp = Kb + (size_t)l32 * NIN + PC_DK + h * 64 + hi * 8;
#pragma unroll
          for (int s = 0; s < 4; ++s) kf[s] = *(const bf16x8*)(kp + s * 16); }
        for (int kt = 0; kt < ntile; ++kt) {
            bf16x8 kn[4], vf[2][2];
#pragma unroll
            for (int dt = 0; dt < 2; ++dt) { const int col = h * 64 + dt * 32 + l32;
                const bf16* vp = Kb + (size_t)((kt >> 1) * 64 + (col >> 3)) * NIN + PC_DV + (col & 7) * 64 + (kt & 1) * 32 + hi * 8;
                vf[dt][0] = *(const bf16x8*)vp; vf[dt][1] = *(const bf16x8*)(vp + 16); }
            { const int ktn = (kt + 1 < ntile) ? kt + 1 : kt;
              const bf16* kp = Kb + (size_t)(ktn * 32 + l32) * NIN + PC_DK + h * 64 + hi * 8;
#pragma unroll
              for (int s = 0; s < 4; ++s) kn[s] = *(const bf16x8*)(kp + s * 16); }
#pragma unroll
            for (int qt = 0; qt < 2; ++qt) {
                f32x16 S;
#pragma unroll
                for (int r = 0; r < 16; ++r) S[r] = 0.f;
#pragma unroll
                for (int s = 0; s < 4; ++s) { const bf16x8 qfr = *(const LAS bf16x8*)(QL + (qt * 32 + l32) * 72 + s * 16 + hi * 8); S = MFMA32(kf[s], qfr, S); }
                const unsigned wsh = BMK[(qt * 32 + l32) * 129 + kt] >> (4 * hi);
                float p[16]; float ls = 0.f;
#pragma unroll
                for (int r = 0; r < 16; ++r) { const int bp = 8 * (r >> 2) + (r & 3); const float e = __builtin_amdgcn_exp2f(S[r] * cs);
                    const int mk = ((int)(wsh << (31 - bp))) >> 31; p[r] = __builtin_bit_cast(float, __builtin_bit_cast(int, e) & mk); ls += p[r]; }
                lsum[qt] += ls;
                bf16x8 pf[2];
#pragma unroll
                for (int s2 = 0; s2 < 2; ++s2) { u32x4 wv; wv.x = pg8::cvt_pk_bf16(p[8 * s2 + 0], p[8 * s2 + 1]); wv.y = pg8::cvt_pk_bf16(p[8 * s2 + 2], p[8 * s2 + 3]); wv.z = pg8::cvt_pk_bf16(p[8 * s2 + 4], p[8 * s2 + 5]); wv.w = pg8::cvt_pk_bf16(p[8 * s2 + 6], p[8 * s2 + 7]);
                    pf[s2] = __builtin_bit_cast(bf16x8, wv); }
#pragma unroll
                for (int dt = 0; dt < 2; ++dt)
#pragma unroll
                    for (int s2 = 0; s2 < 2; ++s2) oacc[dt][qt] = MFMA32(vf[dt][s2], pf[s2], oacc[dt][qt]);
            }
#pragma unroll
            for (int s = 0; s < 4; ++s) kf[s] = kn[s];
        }
#pragma unroll
        for (int qt = 0; qt < 2; ++qt) { const float tot = lsum[qt] + __shfl_xor(lsum[qt], 32); const float inv = 1.0f / tot;
            bf16* orow = O + (size_t)(row0 + qt * 32 + l32) * D + 512 + h * 64;
#pragma unroll
            for (int dt = 0; dt < 2; ++dt)
#pragma unroll
                for (int g = 0; g < 4; ++g) { const int d0 = dt * 32 + 8 * g + 4 * hi;
                    *(u32x2*)(orow + d0) = (u32x2){pk2(oacc[dt][qt][4 * g] * inv, oacc[dt][qt][4 * g + 1] * inv), pk2(oacc[dt][qt][4 * g + 2] * inv, oacc[dt][qt][4 * g + 3] * inv)}; } }
    }
    __syncthreads();
}

#define XB_TMO      128
#define XB_XCNT(j)  (256  + 64 * (j))
#define XB_XSUB(j)  (1280 + 64 * (j))
#define XB_XGEN(j)  (2304 + 64 * (j))
#define XB_TOP      3328
#define XB_TOPGEN   3392
#define XCD_BAR_WORDS 3456
#define XB_SPIN_CAP (1u << 18)

__device__ __forceinline__ unsigned xb_ld(unsigned* p)              { return __hip_atomic_load(p, __ATOMIC_RELAXED, __HIP_MEMORY_SCOPE_AGENT); }
__device__ __forceinline__ unsigned xb_add(unsigned* p, unsigned v) { return __hip_atomic_fetch_add(p, v, __ATOMIC_RELAXED, __HIP_MEMORY_SCOPE_AGENT); }
__device__ __forceinline__ unsigned xb_xcc_id() { return (unsigned)__builtin_amdgcn_s_getreg((3 << 11) | 20) & 0xFu; }
#define XB_SPIN(cond, bar) do { unsigned _sp = 0; while (cond) { __builtin_amdgcn_s_sleep(1); \
    if ((++_sp & 255u) == 0u) { if (xb_ld(&(bar)[XB_TMO])) break; if (_sp > XB_SPIN_CAP) { atomicAdd(&(bar)[XB_TMO], 1u); break; } } } } while (0)

struct XcdBarrier {
    unsigned* bar; unsigned x;
    volatile LAS unsigned* st;
};

__device__ __forceinline__ XcdBarrier xcd_barrier_post(unsigned* bar, volatile LAS unsigned* st) {
    XcdBarrier b; b.bar = bar; b.x = xb_xcc_id(); b.st = st;
    if (threadIdx.x == 0) (void)xb_add(&bar[XB_XCNT(b.x)], 1u);
    return b;
}
__device__ __forceinline__ void xcd_barrier_complete(unsigned* bar, unsigned x, unsigned& nloc, unsigned& nx) {
    const unsigned G = gridDim.x * gridDim.y * gridDim.z;
    unsigned sum, cnt, mine, sp = 0u;
    for (;;) {
        sum = 0u; cnt = 0u; mine = 0u;
#pragma unroll
        for (unsigned j = 0; j < 16; ++j) { const unsigned c = xb_ld(&bar[XB_XCNT(j)]); sum += c; cnt += (c > 0u) ? 1u : 0u; mine = (j == x) ? c : mine; }
        if (sum == G) break;
        __builtin_amdgcn_s_sleep(1);
        if ((++sp & 255u) == 0u) { if (xb_ld(&bar[XB_TMO])) break; if (sp > XB_SPIN_CAP) { atomicAdd(&bar[XB_TMO], 1u); break; } }
    }
    nloc = mine > 0u ? mine : 1u; nx = cnt > 0u ? cnt : 1u;
}

__device__ __forceinline__ void xcd_barrier(const XcdBarrier& b) {
    asm volatile("s_waitcnt vmcnt(0)" ::: "memory");
    __syncthreads();
    if (threadIdx.x == 0) {
        unsigned* bar = b.bar;
        __builtin_amdgcn_s_waitcnt(0);
        unsigned nloc = b.st[0], nx = b.st[1];
        if (nloc == 0u) { xcd_barrier_complete(bar, b.x, nloc, nx); b.st[0] = nloc; b.st[1] = nx; }
        const unsigned old = xb_add(&bar[XB_XSUB(b.x)], 1u);
        const unsigned gen = old / nloc;
        if (old + 1u == (gen + 1u) * nloc) {
            __builtin_amdgcn_fence(__ATOMIC_RELEASE, "agent");
            asm volatile("s_waitcnt vmcnt(0)" ::: "memory");
            const unsigned og = xb_add(&bar[XB_TOP], 1u);
            const unsigned tg = og / nx;
            if (og + 1u == (tg + 1u) * nx) xb_add(&bar[XB_TOPGEN], 1u);
            else XB_SPIN(xb_ld(&bar[XB_TOPGEN]) == tg, bar);
            __builtin_amdgcn_fence(__ATOMIC_ACQUIRE, "agent");
            xb_add(&bar[XB_XGEN(b.x)], 1u);
            asm volatile("s_waitcnt vmcnt(0)" ::: "memory");
        } else {
            XB_SPIN(xb_ld(&bar[XB_XGEN(b.x)]) == gen, bar);
            __builtin_amdgcn_fence(__ATOMIC_ACQUIRE, "agent");
            asm volatile("s_waitcnt vmcnt(0)" ::: "memory");
        }
    }
    __syncthreads();
}

struct Args { const float* in[16]; float* out; unsigned char* ws; };
#define PHASE_BEGIN() \
    const __attribute__((address_space(4))) Args* ap = (const __attribute__((address_space(4))) Args*)__builtin_amdgcn_kernarg_segment_ptr(); asm volatile("" : "+s"(ap)); \
    unsigned char* ws = ap->ws; int tid = threadIdx.x; asm volatile("" : "+v"(tid)); \
    const int lane = tid & 63, wave = __builtin_amdgcn_readfirstlane(tid >> 6); const int G = gridDim.x, bx = blockIdx.x; const int gw = bx * 8 + wave, NGW = G * 8; \
    (void)lane; (void)gw; (void)NGW; (void)ws
__global__ void __launch_bounds__(NTHREADS, 2) hymba_fwd(Args args) {
    extern __shared__ __attribute__((aligned(16))) unsigned char lds_raw[];
    LAS unsigned char* lds = (LAS unsigned char*)lds_raw;
    cg::grid_group grid = cg::this_grid();
    XcdBarrier xbar;
    { volatile LAS unsigned* MISC = (volatile LAS unsigned*)(lds + 131072 + 512);
      if (threadIdx.x < 64) MISC[threadIdx.x] = 0u;
      __syncthreads();
      const __attribute__((address_space(4))) Args* ap0 = (const __attribute__((address_space(4))) Args*)__builtin_amdgcn_kernarg_segment_ptr();
      xbar = xcd_barrier_post((unsigned*)ap0->ws, MISC + 8); }
    {
        PHASE_BEGIN();
        const float* x = ap->in[0]; const float* w_in = ap->in[1]; const float* w_out = ap->in[5];
        const float* f1gu = ap->in[6]; const float* f1d = ap->in[7]; const float* f2gu = ap->in[8]; const float* f2d = ap->in[9];
        bf16 *W1GU = (bf16*)(ws + WS_W1GU), *W1D = (bf16*)(ws + WS_W1D), *WIN = (bf16*)(ws + WS_WIN), *WOUT = (bf16*)(ws + WS_WOUT), *W2GU = (bf16*)(ws + WS_W2GU), *W2D = (bf16*)(ws + WS_W2D);
        bf16* XB = (bf16*)(ws + WS_XB);
        LAS float* scr = (LAS float*)(lds + wave * 16384);
        constexpr int I_GU = (D / 64) * (2 * FF / 32), I_D = (FF / 64) * (D / 32), I_IN = (D / 64) * (NIN / 32), I_OUT = (D / 64) * (D / 32);
        constexpr int NITEMS = 2 * I_GU + 2 * I_D + I_IN + I_OUT;
        for (int it = gw; it < NITEMS; it += NGW) {
            int r = it;
            if (r < I_GU) { transpose_item(f1gu, D, 2 * FF, 2 * FF, W1GU, scr, r, lane, MapGU()); continue; } r -= I_GU;
            if (r < I_GU) { transpose_item(f2gu, D, 2 * FF, 2 * FF, W2GU, scr, r, lane, MapGU()); continue; } r -= I_GU;
            if (r < I_D) { transpose_item(f1d, FF, D, D, W1D, scr, r, lane, MapId()); continue; } r -= I_D;
            if (r < I_D) { transpose_item(f2d, FF, D, D, W2D, scr, r, lane, MapId()); continue; } r -= I_D;
            if (r < I_IN) { transpose_item(w_in, D, IN_TOTAL, NIN, WIN, scr, r, lane, MapIn()); continue; } r -= I_IN;
            transpose_item(w_out, D, D, D, WOUT, scr, r, lane, MapId());
        }
        const size_t n8 = (size_t)M * D / 8;
        for (size_t i = (size_t)bx * NTHREADS + tid; i < n8; i += (size_t)G * NTHREADS) {
            const f32x4 a = ((const f32x4*)x)[2 * i], c = ((const f32x4*)x)[2 * i + 1];
            ((u32x4*)XB)[i] = (u32x4){pk2(a.x, a.y), pk2(a.z, a.w), pk2(c.x, c.y), pk2(c.z, c.w)};
        }
    }
    grid.sync();
    { PHASE_BEGIN(); pg8::Gemm g{(bf16*)(ws + WS_XB), (bf16*)(ws + WS_W1GU), M, 2 * FF, D}; pg8::StaticOrder S; S.init(M, 2 * FF, G, bx); pg8::EpiSwiglu E{(bf16*)(ws + WS_H), FF};
      pg8::gemm_phase<pg8::EpiSwiglu, pg8::StaticOrder, true, true>(lds, g, S, E); }
    xcd_barrier(xbar);
    { PHASE_BEGIN(); pg8::Gemm g{(bf16*)(ws + WS_H), (bf16*)(ws + WS_W1D), M, D, FF}; pg8::StaticOrder S; S.init(M, D, G, bx); pg8::EpiResF32 E{ap->in[0], (float*)(ws + WS_Y), D, ALPHA, 0.5f};
      pg8::gemm_phase<pg8::EpiResF32, pg8::StaticOrder, true, true>(lds, g, S, E); }
    xcd_barrier(xbar);
    { PHASE_BEGIN(); ln_rows((const float*)(ws + WS_Y), ap->in[10], ap->in[11], ap->out, (bf16*)(ws + WS_XB), gw, NGW, lane); }
    xcd_barrier(xbar);
    { PHASE_BEGIN(); pg8::Gemm g{(bf16*)(ws + WS_XB), (bf16*)(ws + WS_WIN), M, NIN, D}; pg8::StaticOrder S; S.init(M, NIN, G, bx); pg8::EpiProj E{(bf16*)(ws + WS_P), NIN, (float*)(ws + WS_PM), NIN / 256 - 1};
      pg8::gemm_phase<pg8::EpiProj, pg8::StaticOrder, true, true>(lds, g, S, E); }
    xcd_barrier(xbar);
    { PHASE_BEGIN();
      for (int it = bx; it < NB * 4 * 64; it += G) gla_g1_item(lds, (const bf16*)(ws + WS_P), (const float*)(ws + WS_PM), ap->in[2], ap->in[3], (float*)(ws + WS_U), (float*)(ws + WS_G), it, tid);
      for (int it = bx; it < NB * 64; it += G) vt_item(lds, (bf16*)(ws + WS_P), it, tid); }
    xcd_barrier(xbar);
    { PHASE_BEGIN(); float* U = (float*)(ws + WS_U); const float* GD = (const float*)(ws + WS_G);
      const int gt = bx * NTHREADS + tid;
      if (gt < NB * 4 * 4096) { const int bh = gt >> 12, e2 = (gt & 4095) * 2, d = e2 & 63; float s0 = 0.f, s1 = 0.f;
#pragma unroll 4
          for (int n = 0; n < 64; ++n) { const int item = bh * 64 + n; float* up = U + (size_t)item * 8192 + e2;
              const float u0 = up[0], u1 = up[1], g0 = GD[item * 64 + d], g1 = GD[item * 64 + d + 1];
              up[0] = s0; up[1] = s1; s0 = g0 * s0 + u0; s1 = g1 * s1 + u1; } } }
    xcd_barrier(xbar);
    { PHASE_BEGIN();
      for (int it = bx; it < NB * 4 * 64; it += G) gla_g3_item(lds, (const bf16*)(ws + WS_P), (const float*)(ws + WS_PM), ap->in[2], ap->in[3], ap->in[4], (const float*)(ws + WS_U), (bf16*)(ws + WS_O), it, tid); }
    xcd_barrier(xbar);
    { PHASE_BEGIN();
      float* scr = (float*)(ws + (bx < 128 ? WS_XB : WS_U)) + ((size_t)(bx & 127) * 8 + wave) * 16384;
      for (int pi = bx; pi < NB * 32; pi += G) { const int b = pi & 7, c1 = pi >> 3;
          dsa_item(lds, (const bf16*)(ws + WS_P), (const float*)(ws + WS_PM), (bf16*)(ws + WS_O), scr, b, 63 - c1, tid);
          dsa_item(lds, (const bf16*)(ws + WS_P), (const float*)(ws + WS_PM), (bf16*)(ws + WS_O), scr, b, c1, tid); } }
    xcd_barrier(xbar);
    { PHASE_BEGIN(); pg8::Gemm g{(bf16*)(ws + WS_O), (bf16*)(ws + WS_WOUT), M, D, D}; pg8::StaticOrder S; S.init(M, D, G, bx); pg8::EpiResF32 E{ap->out, (float*)(ws + WS_Y), D, ALPHA, 1.0f};
      pg8::gemm_phase<pg8::EpiResF32, pg8::StaticOrder, true, true>(lds, g, S, E); }
    xcd_barrier(xbar);
    { PHASE_BEGIN(); ln_rows((const float*)(ws + WS_Y), ap->in[12], ap->in[13], ap->out, (bf16*)(ws + WS_XB), gw, NGW, lane); }
    xcd_barrier(xbar);
    { PHASE_BEGIN(); pg8::Gemm g{(bf16*)(ws + WS_XB), (bf16*)(ws + WS_W2GU), M, 2 * FF, D}; pg8::StaticOrder S; S.init(M, 2 * FF, G, bx); pg8::EpiSwiglu E{(bf16*)(ws + WS_H), FF};
      pg8::gemm_phase<pg8::EpiSwiglu, pg8::StaticOrder, true, true>(lds, g, S, E); }
    xcd_barrier(xbar);
    { PHASE_BEGIN(); pg8::Gemm g{(bf16*)(ws + WS_H), (bf16*)(ws + WS_W2D), M, D, FF}; pg8::StaticOrder S; S.init(M, D, G, bx); pg8::EpiResF32 E{ap->out, (float*)(ws + WS_Y), D, ALPHA, 0.5f};
      pg8::gemm_phase<pg8::EpiResF32, pg8::StaticOrder, true, true>(lds, g, S, E); }
    xcd_barrier(xbar);
    { PHASE_BEGIN(); ln_rows((const float*)(ws + WS_Y), ap->in[14], ap->in[15], ap->out, (bf16*)nullptr, gw, NGW, lane); }
}

extern "C" void kernel_launch(void* const* d_in, const int* in_sizes, int n_in, void* d_out, int out_size, void* d_ws, size_t ws_size, hipStream_t stream) {
    static int grid = 0;
    if (grid == 0) {
        if (n_in != 16 || in_sizes[0] != M * D || out_size != M * D || ws_size < WS_END) { fprintf(stderr, "kernel_launch: unexpected shapes (n_in %d, in0 %d, out %d, ws %zu)\n", n_in, n_in > 0 ? in_sizes[0] : -1, out_size, ws_size); grid = -1; return; }
        int dev = 0, cus = 0, per_cu = 0;
        hipGetDevice(&dev); hipDeviceGetAttribute(&cus, hipDeviceAttributeMultiprocessorCount, dev);
        if (hipFuncSetAttribute((const void*)hymba_fwd, hipFuncAttributeMaxDynamicSharedMemorySize, LDS_BYTES) != hipSuccess) { fprintf(stderr, "kernel_launch: hipFuncSetAttribute failed\n"); grid = -1; return; }
        if (hipOccupancyMaxActiveBlocksPerMultiprocessor(&per_cu, (const void*)hymba_fwd, NTHREADS, LDS_BYTES) != hipSuccess || per_cu < 1) { fprintf(stderr, "kernel_launch: occupancy query says %d blocks per CU\n", per_cu); per_cu = 1; }
        (void)hipGetLastError();
        grid = cus;
    }
    if (grid < 0) return;
    if (hipMemsetAsync(d_ws, 0, 16384, stream) != hipSuccess) { fprintf(stderr, "kernel_launch: memset of the barrier words failed\n"); return; }
    Args a{};
    for (int i = 0; i < 16; ++i) a.in[i] = (const float*)d_in[i];
    a.out = (float*)d_out; a.ws = (unsigned char*)d_ws;
    void* kargs[] = {&a};
    hipError_t e = hipLaunchCooperativeKernel((const void*)hymba_fwd, dim3(grid), dim3(NTHREADS), kargs, LDS_BYTES, stream);
    if (e != hipSuccess) fprintf(stderr, "kernel_launch: cooperative launch failed: %s (grid %d)\n", hipGetErrorString(e), grid);
}
```

```cpp
#include <hip/hip_runtime.h>
#include <hip/hip_cooperative_groups.h>
#include <cstdio>
#include <cstdint>
namespace cg = cooperative_groups;
namespace pg8 {
#define PG8_LAS __attribute__((address_space(3)))
typedef unsigned short bf16_t;
typedef short bf16x8 __attribute__((ext_vector_type(8)));
typedef float f32x4 __attribute__((ext_vector_type(4)));
typedef unsigned u32x4 __attribute__((ext_vector_type(4)));
constexpr int BM = 256, BK = 64, HALF = 128, HTB = HALF * BK * 2  , STAGE_BYTES = 8 * HTB, NXCD = 8, WGM = 8;

__host__ __device__ __forceinline__ int lds_byte(int r, int c) { const int st = (r >> 4) * 2 + (c >> 5), rr = r & 15, cc = c & 31, ob = rr * 64 + cc * 2; return st * 1024 + (ob ^ (((ob >> 9) & 1) << 5)); }
__host__ __device__ __forceinline__ void stage_rc(int b, int& R, int& C) { const int st = b / 1024, sb = b % 1024, swz = sb ^ (((sb >> 9) & 1) << 5); R = (st >> 1) * 16 + swz / 64; C = (st & 1) * 32 + (swz % 64) / 2; }
__host__ __device__ __forceinline__ int perm32(int rho) { const int n = rho >> 4, i = rho & 15; return 8 * (i >> 2) + 4 * n + (i & 3); }

struct Unit { int pm, pn; };
struct Gemm { const bf16_t* A; const bf16_t* Bt; int M, N, K; };

struct StaticOrder {
    int nM, nN, nwg, G, c;
    __host__ __device__ void init(int M, int N, int G_, int c_) { nM = M / BM; nN = N / BM; nwg = nM * nN; G = G_; c = c_; }
    __host__ __device__ bool next(int i, Unit& u) const {
        const long L = (long)i * G + c; if (L >= nwg) return false;
        int wgid = (int)L; { const int q = nwg / NXCD, r = nwg % NXCD, xcd = wgid % NXCD, off = wgid / NXCD; wgid = (xcd < r ? xcd * (q + 1) : r * (q + 1) + (xcd - r) * q) + off; }
        const int nig = WGM * nN, gid = wgid / nig, fm = gid * WGM, gsz = (nM - fm) < WGM ? (nM - fm) : WGM;
        u.pm = fm + ((wgid % nig) % gsz); u.pn = (wgid % nig) / gsz; return true;
    }
    __device__ __forceinline__ void a_ready(const Unit&) const {}
    __device__ __forceinline__ void done(const Unit&) const {}
};

__device__ __forceinline__ unsigned cvt_pk_bf16(float lo, float hi) { unsigned r; asm volatile("v_cvt_pk_bf16_f32 %0, %1, %2" : "=v"(r) : "v"(lo), "v"(hi)); return r; }
typedef float f32x2 __attribute__((ext_vector_type(2)));
__device__ __forceinline__ float silu_f(float g) { return g * __builtin_amdgcn_rcpf(1.0f + __expf(-g)); }
struct EpiSwiglu {
    static constexpr bool PERM = true, AFTER_DRAIN = false;
    bf16_t* O; int ldc;
    __device__ __forceinline__ void operator()(const f32x4 (&acc)[2][2][4][2], const Unit& u, int wr, int wc, int fr, int fq) const {
        asm volatile("" : "+v"(fr), "+v"(fq));
        const int row0 = u.pm * BM + wr * 64 + fr, col0 = u.pn * HALF + wc * 32 + 8 * fq;
#pragma unroll
        for (int ai = 0; ai < 2; ++ai)
#pragma unroll
            for (int m = 0; m < 4; ++m) { bf16_t* rowp = O + (size_t)(row0 + ai * HALF + m * 16) * ldc + col0;
                const f32x4 g0 = acc[ai][0][m][0], g1 = acc[ai][0][m][1], u0 = acc[ai][1][m][0], u1 = acc[ai][1][m][1];
                u32x4 w; w.x = cvt_pk_bf16(silu_f(g0[0]) * u0[0], silu_f(g0[1]) * u0[1]); w.y = cvt_pk_bf16(silu_f(g0[2]) * u0[2], silu_f(g0[3]) * u0[3]);
                w.z = cvt_pk_bf16(silu_f(g1[0]) * u1[0], silu_f(g1[1]) * u1[1]); w.w = cvt_pk_bf16(silu_f(g1[2]) * u1[2], silu_f(g1[3]) * u1[3]);
                *(u32x4*)rowp = w; }
    }
};
struct EpiResF32 {
    static constexpr bool PERM = false, AFTER_DRAIN = false;
    const float* R; float* Y; int ldc; float alpha, scale;
    __device__ __forceinline__ void operator()(const f32x4 (&acc)[2][2][4][2], const Unit& u, int wr, int wc, int fr, int fq) const {
        asm volatile("" : "+v"(fr), "+v"(fq));
        const int col0 = u.pn * BM + wc * 32 + 4 * fq;
#pragma unroll
        for (int ai = 0; ai < 2; ++ai)
#pragma unroll
            for (int m = 0; m < 4; ++m) { const size_t off = (size_t)(u.pm * BM + ai * HALF + wr * 64 + m * 16 + fr) * ldc + col0;
#pragma unroll
                for (int bj = 0; bj < 2; ++bj)
#pragma unroll
                    for (int n = 0; n < 2; ++n) { const f32x4 r = *(const f32x4*)(R + off + bj * HALF + n * 16);
                        *(f32x4*)(Y + off + bj * HALF + n * 16) = r * alpha + acc[ai][bj][m][n] * scale; } }
    }
};
struct EpiProj {
    static constexpr bool PERM = true, AFTER_DRAIN = false;
    bf16_t* O; int ldc; float* PM; int misc_pn;
    __device__ __forceinline__ void operator()(const f32x4 (&acc)[2][2][4][2], const Unit& u, int wr, int wc, int fr, int fq) const {
        asm volatile("" : "+v"(fr), "+v"(fq));
        const int row0 = u.pm * BM + wr * 64 + fr, col0 = u.pn * BM + wc * 32 + 8 * fq;
#pragma unroll
        for (int ai = 0; ai < 2; ++ai)
#pragma unroll
            for (int m = 0; m < 4; ++m) { const int row = row0 + ai * HALF + m * 16; bf16_t* rowp = O + (size_t)row * ldc + col0;
#pragma unroll
                for (int bj = 0; bj < 2; ++bj) { const f32x4 v0 = acc[ai][bj][m][0], v1 = acc[ai][bj][m][1];
                    u32x4 w; w.x = cvt_pk_bf16(v0[0], v0[1]); w.y = cvt_pk_bf16(v0[2], v0[3]); w.z = cvt_pk_bf16(v1[0], v1[1]); w.w = cvt_pk_bf16(v1[2], v1[3]);
                    *(u32x4*)(rowp + bj * HALF) = w; }
                if (u.pn == misc_pn) { float* pm = PM + (size_t)row * 128 + wc * 32 + 8 * fq; *(f32x4*)pm = acc[ai][0][m][0]; *(f32x4*)(pm + 4) = acc[ai][0][m][1]; } }
    }
};

struct EpiResBf16 {
    static constexpr bool PERM = false, AFTER_DRAIN = false;
    const bf16_t* R; float* Y; int ldc; float alpha, scale;
    __device__ __forceinline__ void operator()(const f32x4 (&acc)[2][2][4][2], const Unit& u, int wr, int wc, int fr, int fq) const {
        asm volatile("" : "+v"(fr), "+v"(fq));
        typedef unsigned u32x2v __attribute__((ext_vector_type(2)));
        const int col0 = u.pn * BM + wc * 32 + 4 * fq;
#pragma unroll
        for (int ai = 0; ai < 2; ++ai)
#pragma unroll
            for (int m = 0; m < 4; ++m) { const size_t off = (size_t)(u.pm * BM + ai * HALF + wr * 64 + m * 16 + fr) * ldc + col0;
#pragma unroll
                for (int bj = 0; bj < 2; ++bj)
#pragma unroll
                    for (int n = 0; n < 2; ++n) { const u32x2v rb = *(const u32x2v*)(R + off + bj * HALF + n * 16);
                        const f32x4 r = {__builtin_bit_cast(float, rb.x << 16), __builtin_bit_cast(float, rb.x & 0xffff0000u), __builtin_bit_cast(float, rb.y << 16), __builtin_bit_cast(float, rb.y & 0xffff0000u)};
                        *(f32x4*)(Y + off + bj * HALF + n * 16) = r * alpha + acc[ai][bj][m][n] * scale; } }
    }
};
template <class Epi, class Sched, bool ALIGN_EPI = false, bool SP2 = false>
__device__ __forceinline__ void gemm_phase(PG8_LAS unsigned char* lds, const Gemm g, const Sched& S, const Epi& E) {
    int tid_l = threadIdx.x; asm volatile("" : "+v"(tid_l)); const int tid = tid_l, wid = __builtin_amdgcn_readfirstlane(tid >> 6), lane = tid & 63, wr = wid >> 2, wc = wid & 3, fr = lane & 15, fq = lane >> 4;
    const int K = g.K, nt = K / BK;
    unsigned voffA[2], voffB[2];
#pragma unroll
    for (int i = 0; i < 2; ++i) { int R, C; stage_rc(tid * 16 + i * 8192, R, C); const int Rb = Epi::PERM ? ((R & ~31) + perm32(R & 31)) : R;
        voffA[i] = (unsigned)(R * K + C) * 2u; voffB[i] = (unsigned)(Rb * K + C) * 2u; }
    const size_t kstep = (size_t)(BK * 2);
    const size_t hstep = (size_t)HALF * K * 2;
    const size_t tstep = 2 * hstep;
    const unsigned ldsw = (unsigned)wid * 1024u;
    const int aoff = lds_byte(wr * 64 + fr, fq * 8), boff = lds_byte(wc * 32 + fr, fq * 8);
#define PG8_SA(b, h) (((b) * 2 + (h)) * HTB)
#define PG8_SB(b, h) ((4 + (b) * 2 + (h)) * HTB)
#define PG8_STAGE(bufoff, gbase, voff) do { _Pragma("unroll") for (int _i = 0; _i < 2; ++_i) \
        __builtin_amdgcn_global_load_lds((const unsigned*)((const char*)(gbase) + (voff)[_i]), (PG8_LAS unsigned*)(lds + (bufoff) + ldsw + _i * 8192), 16, 0, 0); } while (0)
#define PG8_LDA(dst, b, h) do { _Pragma("unroll") for (int m = 0; m < 4; ++m) _Pragma("unroll") for (int k = 0; k < 2; ++k) dst[m][k] = *(const PG8_LAS bf16x8*)(lds + PG8_SA(b, h) + aoff + m * 2048 + k * 1024); } while (0)
#define PG8_LDB(dst, b, h) do { _Pragma("unroll") for (int n = 0; n < 2; ++n) _Pragma("unroll") for (int k = 0; k < 2; ++k) dst[n][k] = *(const PG8_LAS bf16x8*)(lds + PG8_SB(b, h) + boff + n * 2048 + k * 1024); } while (0)
#define PG8_MMA(ai, bj, At, Bt) do { __builtin_amdgcn_s_setprio(1); _Pragma("unroll") for (int m = 0; m < 4; ++m) _Pragma("unroll") for (int n = 0; n < 2; ++n) _Pragma("unroll") for (int k = 0; k < 2; ++k) \
        acc[ai][bj][m][n] = __builtin_amdgcn_mfma_f32_16x16x32_bf16(Bt[n][k], At[m][k], acc[ai][bj][m][n], 0, 0, 0); __builtin_amdgcn_s_setprio(0); } while (0)
#define PG8_WAIT_V(n) asm volatile("s_waitcnt vmcnt(" #n ")" ::: "memory")
#define PG8_WAIT_L(n) asm volatile("s_waitcnt lgkmcnt(" #n ")" ::: "memory")
#define PG8_BAR __builtin_amdgcn_s_barrier()
#define PG8_SCHED __builtin_amdgcn_sched_barrier(0)
    Unit cur, nxt; int ui = 0;
    if (!S.next(0, cur)) return;
    f32x4 acc[2][2][4][2];
#pragma unroll
    for (int a = 0; a < 2; ++a)
#pragma unroll
        for (int b = 0; b < 2; ++b)
#pragma unroll
            for (int m = 0; m < 4; ++m)
#pragma unroll
                for (int n = 0; n < 2; ++n) acc[a][b][m][n] = (f32x4){0.f, 0.f, 0.f, 0.f};
    bf16x8 At[4][2], B0[2][2], B1[2][2];
    const char* cA = (const char*)g.A + (size_t)cur.pm * tstep; const char* cB = (const char*)g.Bt + (size_t)cur.pn * tstep;
    S.a_ready(cur);
    if constexpr (SP2) {
        PG8_STAGE(PG8_SB(0, 0), cB, voffB); PG8_STAGE(PG8_SB(0, 1), cB + hstep, voffB); PG8_STAGE(PG8_SA(0, 0), cA, voffA); PG8_STAGE(PG8_SA(0, 1), cA + hstep, voffA);
        if (wr == 1) PG8_BAR;
        PG8_WAIT_V(2); PG8_BAR;
        PG8_STAGE(PG8_SB(1, 0), cB + kstep, voffB); PG8_STAGE(PG8_SA(1, 0), cA + kstep, voffA); PG8_STAGE(PG8_SB(1, 1), cB + hstep + kstep, voffB);
        PG8_WAIT_V(6); PG8_BAR;
    } else {
        PG8_STAGE(PG8_SB(0, 0), cB, voffB); PG8_STAGE(PG8_SA(0, 0), cA, voffA); PG8_STAGE(PG8_SB(0, 1), cB + hstep, voffB); PG8_STAGE(PG8_SA(0, 1), cA + hstep, voffA);
        if (wr == 1) PG8_BAR;
        PG8_WAIT_V(4); PG8_BAR;
        PG8_STAGE(PG8_SB(1, 0), cB + kstep, voffB); PG8_STAGE(PG8_SA(1, 0), cA + kstep, voffA); PG8_STAGE(PG8_SB(1, 1), cB + hstep + kstep, voffB);
        PG8_WAIT_V(6); PG8_BAR;
    }
    for (;;) {
        const bool has_next = S.next(ui + 1, nxt);
        const char* nA = has_next ? (const char*)g.A + (size_t)nxt.pm * tstep : cA; const char* nB = has_next ? (const char*)g.Bt + (size_t)nxt.pn * tstep : cB;
        for (int t = 0; t < nt; t += 2) {
            const bool last = (t == nt - 2);
            const char* a1 = cA + (size_t)(t + 1) * kstep;
            const char* a2 = last ? nA : cA + (size_t)(t + 2) * kstep; const char* b2 = last ? nB : cB + (size_t)(t + 2) * kstep;
            const char* a3 = a2 + kstep; const char* b3 = b2 + kstep;
            if (last && has_next) S.a_ready(nxt);
            if constexpr (SP2) {
            PG8_LDB(B0, 0, 0); PG8_LDB(B1, 0, 1); PG8_SCHED; PG8_LDA(At, 0, 0); PG8_STAGE(PG8_SA(1, 1), a1 + hstep, voffA);
            PG8_WAIT_V(8); PG8_WAIT_L(0); PG8_BAR; PG8_MMA(0, 0, At, B0); PG8_MMA(0, 1, At, B1); PG8_BAR; PG8_SCHED;
            PG8_LDA(At, 0, 1); PG8_STAGE(PG8_SB(0, 0), b2, voffB); PG8_STAGE(PG8_SB(0, 1), b2 + hstep, voffB); PG8_STAGE(PG8_SA(0, 0), a2, voffA);
            PG8_WAIT_V(8); PG8_WAIT_L(0); PG8_BAR; PG8_MMA(1, 0, At, B0); PG8_MMA(1, 1, At, B1); PG8_BAR; PG8_SCHED;
            PG8_LDB(B0, 1, 0); PG8_LDB(B1, 1, 1); PG8_SCHED; PG8_LDA(At, 1, 0); PG8_STAGE(PG8_SA(0, 1), a2 + hstep, voffA);
            PG8_WAIT_V(8); PG8_WAIT_L(0); PG8_BAR; PG8_MMA(0, 0, At, B0); PG8_MMA(0, 1, At, B1); PG8_BAR; PG8_SCHED;
            PG8_LDA(At, 1, 1); PG8_STAGE(PG8_SB(1, 0), b3, voffB); PG8_STAGE(PG8_SB(1, 1), b3 + hstep, voffB); PG8_STAGE(PG8_SA(1, 0), a3, voffA);
            PG8_WAIT_V(8); PG8_WAIT_L(0); PG8_BAR; PG8_MMA(1, 0, At, B0); PG8_MMA(1, 1, At, B1); PG8_BAR; PG8_SCHED;
            } else {
            PG8_LDB(B0, 0, 0); PG8_SCHED; PG8_LDA(At, 0, 0); PG8_STAGE(PG8_SA(1, 1), a1 + hstep, voffA);
            PG8_WAIT_L(8); PG8_BAR; PG8_WAIT_L(0); PG8_MMA(0, 0, At, B0); PG8_BAR; PG8_SCHED;
            PG8_LDB(B1, 0, 1); PG8_STAGE(PG8_SB(0, 0), b2, voffB);
            PG8_BAR; PG8_WAIT_L(0); PG8_MMA(0, 1, At, B1); PG8_BAR;
            PG8_LDA(At, 0, 1); PG8_STAGE(PG8_SA(0, 0), a2, voffA);
            PG8_BAR; PG8_WAIT_L(0); PG8_MMA(1, 0, At, B0); PG8_BAR; PG8_SCHED;
            PG8_STAGE(PG8_SB(0, 1), b2 + hstep, voffB);
            PG8_WAIT_V(6); PG8_BAR; PG8_MMA(1, 1, At, B1); PG8_BAR;
            PG8_LDB(B0, 1, 0); PG8_SCHED; PG8_LDA(At, 1, 0); PG8_STAGE(PG8_SA(0, 1), a2 + hstep, voffA);
            PG8_WAIT_L(8); PG8_BAR; PG8_WAIT_L(0); PG8_MMA(0, 0, At, B0); PG8_BAR; PG8_SCHED;
            PG8_LDB(B1, 1, 1); PG8_STAGE(PG8_SB(1, 0), b3, voffB);
            PG8_BAR; PG8_WAIT_L(0); PG8_MMA(0, 1, At, B1); PG8_BAR;
            PG8_LDA(At, 1, 1); PG8_STAGE(PG8_SA(1, 0), a3, voffA);
            PG8_BAR; PG8_WAIT_L(0); PG8_MMA(1, 0, At, B0); PG8_BAR; PG8_SCHED;
            PG8_STAGE(PG8_SB(1, 1), b3 + hstep, voffB);
            PG8_WAIT_V(6); PG8_BAR; PG8_MMA(1, 1, At, B1); PG8_BAR;
            }
        }
        if constexpr (ALIGN_EPI) { if (wr == 0) PG8_BAR; }
        if constexpr (!Epi::AFTER_DRAIN) { E(acc, cur, wr, wc, fr, fq); S.done(cur); }
        if (!has_next) break;
#pragma unroll
        for (int a = 0; a < 2; ++a)
#pragma unroll
            for (int b = 0; b < 2; ++b)
#pragma unroll
                for (int m = 0; m < 4; ++m)
#pragma unroll
                    for (int n = 0; n < 2; ++n) acc[a][b][m][n] = (f32x4){0.f, 0.f, 0.f, 0.f};
        cur = nxt; cA = nA; cB = nB; ++ui;
        if constexpr (ALIGN_EPI) { if (wr == 1) PG8_BAR; }
    }
    PG8_WAIT_V(0);
    if constexpr (!ALIGN_EPI) { if (wr == 0) PG8_BAR; }
    PG8_BAR;
    if constexpr (Epi::AFTER_DRAIN) { E.fused(acc, cur, wr, wc, fr, fq, lds, wid, lane); S.done(cur); }
#undef PG8_SA
#undef PG8_SB
#undef PG8_STAGE
#undef PG8_LDA
#undef PG8_LDB
#undef PG8_MMA
#undef PG8_WAIT_V
#undef PG8_WAIT_L
#undef PG8_BAR
#undef PG8_SCHED
}
}
constexpr int NB = 8, T = 4096, D = 1024, M = NB * T, FF = 2816, NIN = 3840, IN_TOTAL = 3672;
constexpr int PC_GQ = 0, PC_GK = 256, PC_GV = 512, PC_GG = 1024, PC_DQ = 1536, PC_DK = 2048, PC_DV = 2560, PC_IQ = 3072, PC_IK = 3584, PC_GA = 3648, PC_IW = 3664;
constexpr float LN_EPS = 1e-5f, RMS_EPS = 1e-6f;
constexpr float ALPHA = 1.189207115002721f;
constexpr size_t MiB = 1u << 20;
constexpr size_t WS_W1GU = 2 * MiB, WS_W1D = 13 * MiB, WS_WIN = 19 * MiB, WS_WOUT = 27 * MiB, WS_W2GU = 29 * MiB, WS_W2D = 40 * MiB;
constexpr size_t WS_XB = 50 * MiB, WS_H = 114 * MiB, WS_Y = 290 * MiB, WS_P = 114 * MiB, WS_U = 354 * MiB, WS_O = 418 * MiB, WS_PM = 482 * MiB, WS_G = 498 * MiB, WS_END = 499 * MiB;
constexpr int LDS_BYTES = 147456;
constexpr int NTHREADS = 512;

#define LAS __attribute__((address_space(3)))
typedef unsigned short bf16;
typedef float f32x4 __attribute__((ext_vector_type(4)));
typedef float f32x16 __attribute__((ext_vector_type(16)));
typedef short bf16x8 __attribute__((ext_vector_type(8)));
typedef unsigned u32x4 __attribute__((ext_vector_type(4)));
typedef unsigned u32x2 __attribute__((ext_vector_type(2)));

__device__ __forceinline__ unsigned f2bf(float f) { unsigned u = __builtin_bit_cast(unsigned, f); return (u + 0x7fffu + ((u >> 16) & 1u)) >> 16; }
__device__ __forceinline__ unsigned pk2(float lo, float hi) { return f2bf(lo) | (f2bf(hi) << 16); }
__device__ __forceinline__ float bf2f(unsigned short b) { return __builtin_bit_cast(float, (unsigned)b << 16); }
__device__ __forceinline__ float bflo(unsigned w) { return __builtin_bit_cast(float, w << 16); }
__device__ __forceinline__ float bfhi(unsigned w) { return __builtin_bit_cast(float, w & 0xffff0000u); }
__device__ __forceinline__ float silu(float g) { return g * __builtin_amdgcn_rcpf(1.0f + __expf(-g)); }
__device__ __forceinline__ float wave_sum(float v) {
#pragma unroll
    for (int o = 1; o < 64; o <<= 1) v += __shfl_xor(v, o);
    return v;
}
#define MFMA32(a, b, c) __builtin_amdgcn_mfma_f32_32x32x16_bf16((a), (b), (c), 0, 0, 0)
__device__ __forceinline__ int perm64(int k) { return (k & 32) | (k & 16) | (((k >> 2) & 1) << 3) | (((k >> 3) & 1) << 2) | (k & 3); }

struct MapId { __device__ __forceinline__ int operator()(int n) const { return n; } };
struct MapGU { __device__ __forceinline__ int operator()(int n) const { const int pn = n >> 8, bj = (n >> 7) & 1, j = n & 127; return bj * FF + pn * 128 + j; } };
struct MapIn { __device__ __forceinline__ int operator()(int n) const {
    if (n < 1536) return n;
    if (n < 3584) return n + 16;
    if (n < 3648) return 3600 + (n - 3584);
    if (n < 3664) return 1536 + (n - 3648);
    if (n < 3672) return 3664 + (n - 3664);
    return -1; } };
template <class Map>
__device__ __forceinline__ void transpose_item(const float* W, int K, int N, int ND, bf16* WT, LAS float* scr, int item, int lane, Map map) {
    const int nblk = ND / 32, kb = item / nblk, nb = item % nblk, k0 = 64 * kb, n0 = 32 * nb;
    const int src = map(n0 + (lane & 31));
#pragma unroll 8
    for (int i = 0; i < 32; ++i) { const int kk = 2 * i + (lane >> 5); scr[kk * 33 + (lane & 31)] = src >= 0 ? W[(size_t)(k0 + kk) * N + src] : 0.f; }
    asm volatile("s_waitcnt lgkmcnt(0)" ::: "memory");
    const int c = lane & 7;
#pragma unroll
    for (int j = 0; j < 4; ++j) { const int n = (lane >> 3) + 8 * j; const LAS float* s = scr + (8 * c) * 33 + n;
        u32x4 o; o.x = pk2(s[0 * 33], s[1 * 33]); o.y = pk2(s[2 * 33], s[3 * 33]); o.z = pk2(s[4 * 33], s[5 * 33]); o.w = pk2(s[6 * 33], s[7 * 33]);
        *(u32x4*)(WT + (size_t)(n0 + n) * K + k0 + 8 * c) = o; }
    asm volatile("s_waitcnt lgkmcnt(0)" ::: "memory");
}

__device__ __forceinline__ void ln_rows(const float* Y, const float* g, const float* be, float* Xf, bf16* Xb, int gw, int NGW, int lane) {
    f32x4 gv[4], bv[4];
#pragma unroll
    for (int j = 0; j < 4; ++j) { gv[j] = ((const f32x4*)g)[64 * j + lane]; bv[j] = ((const f32x4*)be)[64 * j + lane]; }
    for (int m = gw; m < M; m += NGW) {
        const f32x4* xr = (const f32x4*)(Y + (size_t)m * D) + lane;
        f32x4 v[4]; float s = 0.f;
#pragma unroll
        for (int j = 0; j < 4; ++j) { v[j] = xr[64 * j]; s += (v[j].x + v[j].y) + (v[j].z + v[j].w); }
        const float mean = wave_sum(s) * (1.f / D); float s2 = 0.f;
#pragma unroll
        for (int j = 0; j < 4; ++j) { v[j] = v[j] - mean; s2 += (v[j].x * v[j].x + v[j].y * v[j].y) + (v[j].z * v[j].z + v[j].w * v[j].w); }
        const float rstd = 1.f / sqrtf(wave_sum(s2) * (1.f / D) + LN_EPS);
#pragma unroll
        for (int j = 0; j < 4; ++j) { const f32x4 o = v[j] * rstd * gv[j] + bv[j];
            if (Xf) ((f32x4*)(Xf + (size_t)m * D))[64 * j + lane] = o;
            if (Xb) { u32x2 w; w.x = pk2(o.x, o.y); w.y = pk2(o.z, o.w); ((u32x2*)(Xb + (size_t)m * D))[64 * j + lane] = w; } }
    }
}

constexpr int GL_BL = 0, GL_SEGT = 16640, GL_QS = 18688, GL_KS = GL_QS + 9216, GL_VT = GL_KS + 9216, GL_ST = GL_VT + 18432, GL_RED = GL_ST + 18432, GL_END = GL_RED + 1024;
__device__ __forceinline__ void gla_b(LAS unsigned char* lds, const float* PM, const float* w2, const float* ba, int row0, int h, int tid) {
    LAS float* BL = (LAS float*)(lds + GL_BL); LAS float* SEGT = (LAS float*)(lds + GL_SEGT);
    const int d = tid & 63, seg = tid >> 6;
    float wcol[16];
#pragma unroll
    for (int r = 0; r < 16; ++r) wcol[r] = w2[r * 256 + h * 64 + d];
    const float bias = ba[h * 64 + d];
    float pre[8]; float run = 0.f;
#pragma unroll
    for (int t = 0; t < 8; ++t) { const float* ga = PM + (size_t)(row0 + seg * 8 + t) * 128 + 64; float z = bias;
#pragma unroll
        for (int r = 0; r < 16; ++r) z += ga[r] * wcol[r];
        const float ls = fminf(z, 0.f) - __logf(1.0f + __expf(-fabsf(z)));
        run += ls * (1.f / 16.f); pre[t] = run; }
    SEGT[seg * 64 + d] = run;
    __syncthreads();
    float off = 0.f;
#pragma unroll
    for (int s = 0; s < 8; ++s) off += (s < seg) ? SEGT[s * 64 + d] : 0.f;
#pragma unroll
    for (int t = 0; t < 8; ++t) BL[(seg * 8 + t) * 65 + d] = pre[t] + off;
    __syncthreads();
}
__device__ __forceinline__ void gla_stage_vt(LAS unsigned char* lds, const bf16* P, int row0, int h, int tid) {
    LAS bf16* VT = (LAS bf16*)(lds + GL_VT);
#pragma unroll
    for (int i = 0; i < 2; ++i) { const int piece = tid + i * NTHREADS, j = piece >> 4, c = piece & 15, pj = perm64(j);
        const u32x4 v = *(const u32x4*)(P + (size_t)(row0 + j) * NIN + PC_GV + h * 128 + c * 8);
        VT[(c * 8 + 0) * 72 + pj] = (bf16)(v.x & 0xffff); VT[(c * 8 + 1) * 72 + pj] = (bf16)(v.x >> 16);
        VT[(c * 8 + 2) * 72 + pj] = (bf16)(v.y & 0xffff); VT[(c * 8 + 3) * 72 + pj] = (bf16)(v.y >> 16);
        VT[(c * 8 + 4) * 72 + pj] = (bf16)(v.z & 0xffff); VT[(c * 8 + 5) * 72 + pj] = (bf16)(v.z >> 16);
        VT[(c * 8 + 6) * 72 + pj] = (bf16)(v.w & 0xffff); VT[(c * 8 + 7) * 72 + pj] = (bf16)(v.w >> 16); }
}
__device__ __forceinline__ void gla_g1_item(LAS unsigned char* lds, const bf16* P, const float* PM, const float* w2, const float* ba, float* U, float* G, int item, int tid) {
    const int bh = item >> 6, n = item & 63, b = bh >> 2, h = bh & 3, row0 = b * T + n * 64;
    const int lane = tid & 63, wave = tid >> 6, l32 = lane & 31, hi = lane >> 5;
    gla_b(lds, PM, w2, ba, row0, h, tid);
    LAS float* BL = (LAS float*)(lds + GL_BL); LAS bf16* KHT = (LAS bf16*)(lds + GL_QS); LAS bf16* VT = (LAS bf16*)(lds + GL_VT);
    { const int j = tid >> 3, dg = tid & 7, pj = perm64(j);
      const u32x4 kv = *(const u32x4*)(P + (size_t)(row0 + j) * NIN + PC_GK + h * 64 + dg * 8);
      const unsigned kw[4] = {kv.x, kv.y, kv.z, kv.w};
#pragma unroll
      for (int e = 0; e < 8; ++e) { const int d = dg * 8 + e; const float kf = (e & 1) ? bfhi(kw[e >> 1]) : bflo(kw[e >> 1]);
          KHT[d * 72 + pj] = (bf16)f2bf(kf * __expf(BL[63 * 65 + d] - BL[j * 65 + d])); } }
    gla_stage_vt(lds, P, row0, h, tid);
    __syncthreads();
    { const int dvt = wave & 3, dt = wave >> 2;
      f32x16 acc;
#pragma unroll
      for (int r = 0; r < 16; ++r) acc[r] = 0.f;
#pragma unroll
      for (int s = 0; s < 4; ++s) { const bf16x8 a = *(const LAS bf16x8*)(VT + (dvt * 32 + l32) * 72 + s * 16 + hi * 8); const bf16x8 bb = *(const LAS bf16x8*)(KHT + (dt * 32 + l32) * 72 + s * 16 + hi * 8);
          acc = MFMA32(a, bb, acc); }
#pragma unroll
      for (int r = 0; r < 16; ++r) { const int dv = dvt * 32 + 8 * (r >> 2) + 4 * hi + (r & 3); U[((size_t)item * 128 + dv) * 64 + dt * 32 + l32] = acc[r]; } }
    if (tid < 64) G[item * 64 + tid] = __expf(BL[63 * 65 + tid]);
    __syncthreads();
}
__device__ __forceinline__ void gla_g3_item(LAS unsigned char* lds, const bf16* P, const float* PM, const float* w2, const float* ba, const float* gnorm, const float* U, bf16* O, int item, int tid) {
    const int bh = item >> 6, n = item & 63, b = bh >> 2, h = bh & 3, row0 = b * T + n * 64;
    const int lane = tid & 63, wave = tid >> 6, l32 = lane & 31, hi = lane >> 5;
    gla_b(lds, PM, w2, ba, row0, h, tid);
    LAS float* BL = (LAS float*)(lds + GL_BL); LAS bf16* QS = (LAS bf16*)(lds + GL_QS); LAS bf16* KS = (LAS bf16*)(lds + GL_KS);
    LAS bf16* VT = (LAS bf16*)(lds + GL_VT); LAS bf16* ST = (LAS bf16*)(lds + GL_ST); LAS float* RED = (LAS float*)(lds + GL_RED);
    { const int i = tid >> 3, dg = tid & 7;
      const u32x4 qv = *(const u32x4*)(P + (size_t)(row0 + i) * NIN + PC_GQ + h * 64 + dg * 8);
      const u32x4 kv = *(const u32x4*)(P + (size_t)(row0 + i) * NIN + PC_GK + h * 64 + dg * 8);
      const unsigned qw[4] = {qv.x, qv.y, qv.z, qv.w}, kw[4] = {kv.x, kv.y, kv.z, kv.w};
      unsigned qo[4], ko[4];
#pragma unroll
      for (int e2 = 0; e2 < 4; ++e2) { const float b0 = BL[i * 65 + dg * 8 + 2 * e2], b1 = BL[i * 65 + dg * 8 + 2 * e2 + 1];
          qo[e2] = pk2(bflo(qw[e2]) * __expf(b0) * 0.125f, bfhi(qw[e2]) * __expf(b1) * 0.125f);
          ko[e2] = pk2(bflo(kw[e2]) * __expf(-b0), bfhi(kw[e2]) * __expf(-b1)); }
      *(LAS u32x4*)(QS + i * 72 + dg * 8) = (u32x4){qo[0], qo[1], qo[2], qo[3]};
      *(LAS u32x4*)(KS + i * 72 + dg * 8) = (u32x4){ko[0], ko[1], ko[2], ko[3]}; }
    gla_stage_vt(lds, P, row0, h, tid);
#pragma unroll
    for (int i = 0; i < 4; ++i) { const int idx4 = tid + i * NTHREADS, dv = idx4 >> 4, d4 = (idx4 & 15) * 4;
        const f32x4 s = *(const f32x4*)(U + ((size_t)item * 128 + dv) * 64 + d4);
        *(LAS u32x2*)(ST + dv * 72 + d4) = (u32x2){pk2(s.x, s.y), pk2(s.z, s.w)}; }
    __syncthreads();
    const int dvt = wave & 3, it = wave >> 2;
    f32x16 o;
    {
      bf16x8 qfr[4];
#pragma unroll
      for (int s = 0; s < 4; ++s) qfr[s] = *(const LAS bf16x8*)(QS + (it * 32 + l32) * 72 + s * 16 + hi * 8);
      bf16x8 pf[2][2];
#pragma unroll
      for (int jt = 0; jt < 2; ++jt) { f32x16 a;
#pragma unroll
          for (int r = 0; r < 16; ++r) a[r] = 0.f;
#pragma unroll
          for (int s = 0; s < 4; ++s) { const bf16x8 kf = *(const LAS bf16x8*)(KS + (jt * 32 + l32) * 72 + s * 16 + hi * 8); a = MFMA32(kf, qfr[s], a); }
          const int i = it * 32 + l32;
#pragma unroll
          for (int r = 0; r < 16; ++r) { const int j = jt * 32 + 8 * (r >> 2) + 4 * hi + (r & 3); a[r] = (j <= i) ? a[r] : 0.f; }
#pragma unroll
          for (int s2 = 0; s2 < 2; ++s2) { u32x4 w; w.x = pk2(a[8 * s2 + 0], a[8 * s2 + 1]); w.y = pk2(a[8 * s2 + 2], a[8 * s2 + 3]); w.z = pk2(a[8 * s2 + 4], a[8 * s2 + 5]); w.w = pk2(a[8 * s2 + 6], a[8 * s2 + 7]);
              pf[jt][s2] = __builtin_bit_cast(bf16x8, w); } }
#pragma unroll
      for (int r = 0; r < 16; ++r) o[r] = 0.f;
#pragma unroll
      for (int jt = 0; jt < 2; ++jt)
#pragma unroll
          for (int s2 = 0; s2 < 2; ++s2) { const bf16x8 vf = *(const LAS bf16x8*)(VT + (dvt * 32 + l32) * 72 + jt * 32 + s2 * 16 + hi * 8); o = MFMA32(vf, pf[jt][s2], o); }
#pragma unroll
      for (int s = 0; s < 4; ++s) { const bf16x8 sf = *(const LAS bf16x8*)(ST + (dvt * 32 + l32) * 72 + s * 16 + hi * 8); o = MFMA32(sf, qfr[s], o); }
    }
    float ss = 0.f;
#pragma unroll
    for (int r = 0; r < 16; ++r) ss += o[r] * o[r];
    ss += __shfl_xor(ss, 32);
    if (hi == 0) RED[dvt * 64 + it * 32 + l32] = ss;
    __syncthreads();
    { const int i = it * 32 + l32; const float tot = RED[i] + RED[64 + i] + RED[128 + i] + RED[192 + i];
      const float rs = 1.0f / sqrtf(tot * (1.f / 128.f) + RMS_EPS);
#pragma unroll
      for (int g = 0; g < 4; ++g) { const int dv0 = dvt * 32 + 8 * g + 4 * hi;
          const u32x2 gg = *(const u32x2*)(P + (size_t)(row0 + i) * NIN + PC_GG + h * 128 + dv0);
          const f32x4 gn = *(const f32x4*)(gnorm + dv0);
          const float o0 = o[4 * g + 0] * rs * gn.x * silu(bflo(gg.x)), o1 = o[4 * g + 1] * rs * gn.y * silu(bfhi(gg.x));
          const float o2 = o[4 * g + 2] * rs * gn.z * silu(bflo(gg.y)), o3 = o[4 * g + 3] * rs * gn.w * silu(bfhi(gg.y));
          *(u32x2*)(O + (size_t)(row0 + i) * D + h * 128 + dv0) = (u32x2){pk2(o0, o1), pk2(o2, o3)}; } }
    __syncthreads();
}
__device__ __forceinline__ void vt_item(LAS unsigned char* lds, bf16* P, int item, int tid) {
    const int row0 = item * 64;
    LAS bf16* LV = (LAS bf16*)lds;
#pragma unroll
    for (int i = 0; i < 8; ++i) { const int piece = tid + i * NTHREADS, key = piece >> 6, c16 = piece & 63;
        *(LAS u32x4*)(LV + key * 520 + c16 * 8) = *(const u32x4*)(P + (size_t)(row0 + key) * NIN + PC_DV + c16 * 8); }
    __syncthreads();
    const int col = tid; bf16* dst = P + (size_t)(row0 + (col >> 3)) * NIN + PC_DV + (col & 7) * 64;
#pragma unroll
    for (int pg = 0; pg < 8; ++pg) { unsigned e[8];
#pragma unroll
        for (int jj = 0; jj < 8; ++jj) { const int pos = pg * 8 + jj; const int key = (pos & 32) + (pos & 16) + 8 * (jj >> 2) + 4 * ((pos >> 3) & 1) + (jj & 3); e[jj] = LV[key * 520 + col]; }
        *(u32x4*)(dst + pg * 8) = (u32x4){e[0] | (e[1] << 16), e[2] | (e[3] << 16), e[4] | (e[5] << 16), e[6] | (e[7] << 16)}; }
    __syncthreads();
}

__device__ __forceinline__ unsigned okey(float x) { unsigned bits = __builtin_bit_cast(unsigned, x); if (bits == 0x80000000u) bits = 0u; return bits ^ ((unsigned)((int)bits >> 31) | 0x80000000u); }
__device__ __forceinline__ void dsa_item(LAS unsigned char* lds, const bf16* P, const float* PM, bf16* O, float* scr, int b, int c, int tid) {
    LAS unsigned* BMK = (LAS unsigned*)lds;
    const int lane = tid & 63, wave = __builtin_amdgcn_readfirstlane(tid >> 6), l32 = lane & 31, hi = lane >> 5;
    const int row0 = b * T + c * 64, nk64 = c + 1;
    const bf16* Kb = P + (size_t)(b * T) * NIN;
    for (int rt = 0; rt < 2; ++rt) {
        const int qbase = row0 + wave * 8 + rt * 4;
        {
            bf16x8 qf[4];
            { const int hh = l32 >> 2, q = l32 & 3; const bf16* qp = P + (size_t)(qbase + q) * NIN + PC_IQ + hh * 64 + hi * 8;
#pragma unroll
              for (int s = 0; s < 4; ++s) qf[s] = *(const bf16x8*)(qp + s * 16); }
            float w[4][4];
#pragma unroll
            for (int q = 0; q < 4; ++q)
#pragma unroll
                for (int g = 0; g < 4; ++g) w[q][g] = PM[(size_t)(qbase + q) * 128 + 80 + 2 * g + hi] * (0.125f * 0.35355339059327373f);
            LAS bf16* KI = (LAS bf16*)(lds + 33280);
            const int ldkey = tid >> 3, ldpart = tid & 7;
            const bf16* gsrc = Kb + (size_t)ldkey * NIN + PC_IK + ldpart * 8;
            u32x4 stg = *(const u32x4*)gsrc;
            *(LAS u32x4*)(KI + ldkey * 72 + ldpart * 8) = stg;
            __syncthreads();
            for (int kb = 0; kb < nk64; ++kb) {
                if (kb + 1 < nk64) stg = *(const u32x4*)(gsrc + (size_t)(kb + 1) * 64 * NIN);
                const LAS bf16* kbuf = KI + (kb & 1) * 4608;
#pragma unroll
                for (int sub = 0; sub < 2; ++sub) {
                    f32x16 acc;
#pragma unroll
                    for (int r = 0; r < 16; ++r) acc[r] = 0.f;
#pragma unroll
                    for (int s = 0; s < 4; ++s) { const bf16x8 kf = *(const LAS bf16x8*)(kbuf + (sub * 32 + l32) * 72 + s * 16 + hi * 8); acc = MFMA32(qf[s], kf, acc); }
                    float part[4];
#pragma unroll
                    for (int q = 0; q < 4; ++q) { float p = 0.f;
#pragma unroll
                        for (int g = 0; g < 4; ++g) p += w[q][g] * fmaxf(acc[4 * g + q], 0.f);
                        part[q] = p + __shfl_xor(p, 32); }
                    const float a0 = hi ? part[2] : part[0], a1 = hi ? part[3] : part[1];
                    scr[(2 * hi) * 4096 + kb * 64 + sub * 32 + l32] = a0; scr[(2 * hi + 1) * 4096 + kb * 64 + sub * 32 + l32] = a1;
                }
                if (kb + 1 < nk64) *(LAS u32x4*)(KI + ((kb + 1) & 1) * 4608 + ldkey * 72 + ldpart * 8) = stg;
                __syncthreads();
            }
        }
        __builtin_amdgcn_fence(__ATOMIC_RELEASE, "workgroup"); asm volatile("s_waitcnt vmcnt(0)" ::: "memory");
        __builtin_amdgcn_fence(__ATOMIC_ACQUIRE, "workgroup");
        for (int q = 0; q < 4; ++q) {
            LAS unsigned* bmrow = BMK + (wave * 8 + rt * 4 + q) * 129;
            if (c < 4) {
                for (int j = 0; j <= c; ++j) if (lane < 2) bmrow[2 * j + lane] = 0xffffffffu;
            } else {
                unsigned kx[64];
#pragma unroll
                for (int g = 0; g < 4; ++g) {
                    if (g * 16 <= c) {
#pragma unroll
                        for (int jj = 0; jj < 16; ++jj) { const int j = g * 16 + jj; unsigned bits = __builtin_bit_cast(unsigned, scr[q * 4096 + j * 64 + lane]); if (bits == 0x80000000u) bits = 0u; kx[j] = (j <= c) ? bits : 0xff800000u; }
                    } else {
#pragma unroll
                        for (int jj = 0; jj < 16; ++jj) kx[g * 16 + jj] = 0xff800000u;
                    }
                }
                LAS unsigned* HIST = (LAS unsigned*)(lds + 51712 + wave * 6656); LAS unsigned* LIST = HIST + 1024; LAS unsigned* DENSE = LIST + 512;
#pragma unroll
                for (int i = 0; i < 4; ++i) *(LAS u32x4*)(HIST + i * 256 + lane * 4) = (u32x4){0u, 0u, 0u, 0u};
#pragma unroll
                for (int g = 0; g < 4; ++g) if (g * 16 <= c) {
#pragma unroll
                    for (int jj = 0; jj < 16; ++jj) { int bi = (int)__builtin_fmaf(__builtin_bit_cast(float, kx[g * 16 + jj]), 64.f, 512.f); bi = min(max(bi, 0), 1023);
                        __hip_atomic_fetch_add(HIST + bi, 1u, __ATOMIC_RELAXED, __HIP_MEMORY_SCOPE_WORKGROUP); }
                }
                int bstar, nb, cabove;
                { unsigned hs[16];
#pragma unroll
                  for (int i = 0; i < 4; ++i) { const u32x4 v = *(const LAS u32x4*)(HIST + lane * 16 + i * 4); hs[4 * i] = v.x; hs[4 * i + 1] = v.y; hs[4 * i + 2] = v.z; hs[4 * i + 3] = v.w; }
                  unsigned tl = 0;
#pragma unroll
                  for (int i = 0; i < 16; ++i) tl += hs[i];
                  unsigned incl = tl;
#pragma unroll
                  for (int o = 1; o < 64; o <<= 1) { const unsigned t = __shfl_down(incl, o); incl += (lane + o < 64) ? t : 0u; }
                  const unsigned above = incl - tl;
                  const unsigned long long own = __ballot(above < 256u && incl >= 256u);
                  unsigned cum = above; int lb = 0, lnb = 0, lca = 0; bool found = false;
#pragma unroll
                  for (int i = 15; i >= 0; --i) { const bool hit = !found && (cum + hs[i] >= 256u); lb = hit ? i : lb; lnb = hit ? (int)hs[i] : lnb; lca = hit ? (int)cum : lca; found = found || hit; cum += hs[i]; }
                  const int ol = own ? (int)__builtin_ctzll(own) : 0;
                  bstar = __shfl(lb, ol) + 16 * ol; nb = __shfl(lnb, ol); cabove = __shfl(lca, ol);
                  if (!own) bstar = 0; }
                bool fast = (bstar > 0) && (bstar < 1023) && (nb <= 64);
                unsigned thrbits = 0u; int n_ge = 0, need = 256 - cabove; unsigned ck = 0u, thr = 0u;
                if (fast) {
                    unsigned kt = 0;
#pragma unroll
                    for (int g = 0; g < 4; ++g) if (g * 16 <= c) {
#pragma unroll
                        for (int jj = 0; jj < 16; ++jj) { const unsigned v = kx[g * 16 + jj]; int bi = (int)__builtin_fmaf(__builtin_bit_cast(float, v), 64.f, 512.f); bi = min(max(bi, 0), 1023);
                            LIST[min(kt, 7u) * 64 + lane] = v; kt += (bi == bstar) ? 1u : 0u; }
                    }
                    if (__ballot(kt > 8u)) fast = false;
                    else {
                        unsigned incl = kt;
#pragma unroll
                        for (int o = 1; o < 64; o <<= 1) { const unsigned t = __shfl_up(incl, o); incl += (lane >= o) ? t : 0u; }
                        const unsigned off = incl - kt;
#pragma unroll
                        for (int i = 0; i < 8; ++i) if ((unsigned)i < kt) DENSE[off + i] = LIST[i * 64 + lane];
                        const unsigned cb = (lane < nb) ? DENSE[lane] : 0xff800000u;
                        ck = (lane < nb) ? (cb ^ ((unsigned)((int)cb >> 31) | 0x80000000u)) : 0u;
                        for (int bit = 31; bit >= 0; --bit) { const unsigned cand = thr | (1u << bit); if ((int)__popcll(__ballot(ck >= cand)) >= need) thr = cand; }
                        n_ge = (int)__popcll(__ballot(ck >= thr));
                        thrbits = (thr & 0x80000000u) ? (thr ^ 0x80000000u) : ~thr;
                    }
                }
                if (fast) {
                    const float thrf = __builtin_bit_cast(float, thrbits);
                    if (n_ge == need) {
#pragma unroll
                        for (int g = 0; g < 4; ++g) if (g * 16 <= c) {
#pragma unroll
                            for (int jj = 0; jj < 16; ++jj) { const int j = g * 16 + jj; const unsigned long long mm = __ballot(__builtin_bit_cast(float, kx[j]) >= thrf);
                                if (lane < 2) bmrow[2 * j + lane] = lane ? (unsigned)(mm >> 32) : (unsigned)mm; }
                        }
                    } else {
                        int need2 = need - (int)__popcll(__ballot(ck > thr));
#pragma unroll
                        for (int g = 0; g < 4; ++g) if (g * 16 <= c) {
#pragma unroll
                            for (int jj = 0; jj < 16; ++jj) { const int j = g * 16 + jj; const float xv = __builtin_bit_cast(float, kx[j]);
                                const unsigned long long gt = __ballot(xv > thrf); unsigned long long eq = __ballot(xv == thrf);
                                int ne = __popcll(eq);
                                while (ne > need2) { eq &= ~(1ull << (63 - __clzll((long long)eq))); --ne; }
                                need2 -= ne;
                                const unsigned long long mm = gt | eq;
                                if (lane < 2) bmrow[2 * j + lane] = lane ? (unsigned)(mm >> 32) : (unsigned)mm; }
                        }
                    }
                } else {
#pragma unroll
                    for (int j = 0; j < 64; ++j) { const unsigned b = kx[j]; kx[j] = (b == 0xff800000u) ? 0u : (b ^ ((unsigned)((int)b >> 31) | 0x80000000u)); }
                    unsigned cur = 0u;
                    for (int bit = 31; bit >= 0; --bit) {
                        const unsigned cand = cur | (1u << bit); int cnt = 0;
#pragma unroll
                        for (int g = 0; g < 4; ++g) if (g * 16 <= c) {
#pragma unroll
                            for (int jj = 0; jj < 16; ++jj) cnt += __popcll(__ballot(kx[g * 16 + jj] >= cand));
                        }
                        if (cnt >= 256) cur = cand;
                    }
                    int cgt = 0;
#pragma unroll
                    for (int g = 0; g < 4; ++g) if (g * 16 <= c) {
#pragma unroll
                        for (int jj = 0; jj < 16; ++jj) cgt += __popcll(__ballot(kx[g * 16 + jj] > cur));
                    }
                    int need3 = 256 - cgt;
#pragma unroll
                    for (int g = 0; g < 4; ++g) if (g * 16 <= c) {
#pragma unroll
                        for (int jj = 0; jj < 16; ++jj) { const int j = g * 16 + jj;
                            const unsigned long long gt = __ballot(kx[j] > cur); unsigned long long eq = __ballot(kx[j] == cur);
                            int ne = __popcll(eq);
                            while (ne > need3) { eq &= ~(1ull << (63 - __clzll((long long)eq))); --ne; }
                            need3 -= ne;
                            const unsigned long long mm = gt | eq;
                            if (lane < 2) bmrow[2 * j + lane] = lane ? (unsigned)(mm >> 32) : (unsigned)mm; }
                    }
                }
            }
        }
    }
    __syncthreads();
    {
        const int h = wave;
        LAS bf16* QL = (LAS bf16*)(lds + 33280 + wave * 9216);
        { const bf16* qp = P + (size_t)(row0 + lane) * NIN + PC_DQ + h * 64;
#pragma unroll
          for (int pc = 0; pc < 8; ++pc) *(LAS u32x4*)(QL + lane * 72 + pc * 8) = *(const u32x4*)(qp + pc * 8); }
        f32x16 oacc[2][2];
#pragma unroll
        for (int a = 0; a < 2; ++a)
#pragma unroll
            for (int bq = 0; bq < 2; ++bq)
#pragma unroll
                for (int r = 0; r < 16; ++r) oacc[a][bq][r] = 0.f;
        float lsum[2] = {0.f, 0.f};
        const float cs = 0.125f * 1.4426950408889634f;
        const int ntile = 2 * nk64;
        bf16x8 kf[4];
        { const bf16* kp = Kb + (size_t)l32 * NIN + PC_DK + h * 64 + hi * 8;
#pragma unroll
          for (int s = 0; s < 4; ++s) kf[s] = *(const bf16x8*)(kp + s * 16); }
        for (int kt = 0; kt < ntile; ++kt) {
            bf16x8 kn[4], vf[2][2];
#pragma unroll
            for (int dt = 0; dt < 2; ++dt) { const int col = h * 64 + dt * 32 + l32;
                const bf16* vp = Kb + (size_t)((kt >> 1) * 64 + (col >> 3)) * NIN + PC_DV + (col & 7) * 64 + (kt & 1) * 32 + hi * 8;
                vf[dt][0] = *(const bf16x8*)vp; vf[dt][1] = *(const bf16x8*)(vp + 16); }
            { const int ktn = (kt + 1 < ntile) ? kt + 1 : kt;
              const bf16* kp = Kb + (size_t)(ktn * 32 + l32) * NIN + PC_DK + h * 64 + hi * 8;
#pragma unroll
              for (int s = 0; s < 4; ++s) kn[s] = *(const bf16x8*)(kp + s * 16); }
#pragma unroll
            for (int qt = 0; qt < 2; ++qt) {
                f32x16 S;
#pragma unroll
                for (int r = 0; r < 16; ++r) S[r] = 0.f;
#pragma unroll
                for (int s = 0; s < 4; ++s) { const bf16x8 qfr = *(const LAS bf16x8*)(QL + (qt * 32 + l32) * 72 + s * 16 + hi * 8); S = MFMA32(kf[s], qfr, S); }
                const unsigned wsh = BMK[(qt * 32 + l32) * 129 + kt] >> (4 * hi);
                float p[16]; float ls = 0.f;
#pragma unroll
                for (int r = 0; r < 16; ++r) { const int bp = 8 * (r >> 2) + (r & 3); const float e = __builtin_amdgcn_exp2f(S[r] * cs);
                    const int mk = ((int)(wsh << (31 - bp))) >> 31; p[r] = __builtin_bit_cast(float, __builtin_bit_cast(int, e) & mk); ls += p[r]; }
                lsum[qt] += ls;
                bf16x8 pf[2];
#pragma unroll
                for (int s2 = 0; s2 < 2; ++s2) { u32x4 wv; wv.x = pg8::cvt_pk_bf16(p[8 * s2 + 0], p[8 * s2 + 1]); wv.y = pg8::cvt_pk_bf16(p[8 * s2 + 2], p[8 * s2 + 3]); wv.z = pg8::cvt_pk_bf16(p[8 * s2 + 4], p[8 * s2 + 5]); wv.w = pg8::cvt_pk_bf16(p[8 * s2 + 6], p[8 * s2 + 7]);
                    pf[s2] = __builtin_bit_cast(bf16x8, wv); }
#pragma unroll
                for (int dt = 0; dt < 2; ++dt)
#pragma unroll
                    for (int s2 = 0; s2 < 2; ++s2) oacc[dt][qt] = MFMA32(vf[dt][s2], pf[s2], oacc[dt][qt]);
            }
#pragma unroll
            for (int s = 0; s < 4; ++s) kf[s] = kn[s];
        }
#pragma unroll
        for (int qt = 0; qt < 2; ++qt) { const float tot = lsum[qt] + __shfl_xor(lsum[qt], 32); const float inv = 1.0f / tot;
            bf16* orow = O + (size_t)(row0 + qt * 32 + l32) * D + 512 + h * 64;
#pragma unroll
            for (int dt = 0; dt < 2; ++dt)
#pragma unroll
                for (int g = 0; g < 4; ++g) { const int d0 = dt * 32 + 8 * g + 4 * hi;
                    *(u32x2*)(orow + d0) = (u32x2){pk2(oacc[dt][qt][4 * g] * inv, oacc[dt][qt][4 * g + 1] * inv), pk2(oacc[dt][qt][4 * g + 2] * inv, oacc[dt][qt][4 * g + 3] * inv)}; } }
    }
    __syncthreads();
}

#define XB_TMO      128
#define XB_XCNT(j)  (256  + 64 * (j))
#define XB_XSUB(j)  (1280 + 64 * (j))
#define XB_XGEN(j)  (2304 + 64 * (j))
#define XB_TOP      3328
#define XB_TOPGEN   3392
#define XCD_BAR_WORDS 3456
#define XB_SPIN_CAP (1u << 18)

__device__ __forceinline__ unsigned xb_ld(unsigned* p)              { return __hip_atomic_load(p, __ATOMIC_RELAXED, __HIP_MEMORY_SCOPE_AGENT); }
__device__ __forceinline__ unsigned xb_add(unsigned* p, unsigned v) { return __hip_atomic_fetch_add(p, v, __ATOMIC_RELAXED, __HIP_MEMORY_SCOPE_AGENT); }
__device__ __forceinline__ unsigned xb_xcc_id() { return (unsigned)__builtin_amdgcn_s_getreg((3 << 11) | 20) & 0xFu; }
#define XB_SPIN(cond, bar) do { unsigned _sp = 0; while (cond) { __builtin_amdgcn_s_sleep(1); \
    if ((++_sp & 255u) == 0u) { if (xb_ld(&(bar)[XB_TMO])) break; if (_sp > XB_SPIN_CAP) { atomicAdd(&(bar)[XB_TMO], 1u); break; } } } } while (0)

struct XcdBarrier {
    unsigned* bar; unsigned x;
    volatile LAS unsigned* st;
};

__device__ __forceinline__ XcdBarrier xcd_barrier_post(unsigned* bar, volatile LAS unsigned* st) {
    XcdBarrier b; b.bar = bar; b.x = xb_xcc_id(); b.st = st;
    if (threadIdx.x == 0) (void)xb_add(&bar[XB_XCNT(b.x)], 1u);
    return b;
}
__device__ __forceinline__ void xcd_barrier_complete(unsigned* bar, unsigned x, unsigned& nloc, unsigned& nx) {
    const unsigned G = gridDim.x * gridDim.y * gridDim.z;
    unsigned sum, cnt, mine, sp = 0u;
    for (;;) {
        sum = 0u; cnt = 0u; mine = 0u;
#pragma unroll
        for (unsigned j = 0; j < 16; ++j) { const unsigned c = xb_ld(&bar[XB_XCNT(j)]); sum += c; cnt += (c > 0u) ? 1u : 0u; mine = (j == x) ? c : mine; }
        if (sum == G) break;
        __builtin_amdgcn_s_sleep(1);
        if ((++sp & 255u) == 0u) { if (xb_ld(&bar[XB_TMO])) break; if (sp > XB_SPIN_CAP) { atomicAdd(&bar[XB_TMO], 1u); break; } }
    }
    nloc = mine > 0u ? mine : 1u; nx = cnt > 0u ? cnt : 1u;
}

__device__ __forceinline__ void xcd_barrier(const XcdBarrier& b) {
    asm volatile("s_waitcnt vmcnt(0)" ::: "memory");
    __syncthreads();
    if (threadIdx.x == 0) {
        unsigned* bar = b.bar;
        __builtin_amdgcn_s_waitcnt(0);
        unsigned nloc = b.st[0], nx = b.st[1];
        if (nloc == 0u) { xcd_barrier_complete(bar, b.x, nloc, nx); b.st[0] = nloc; b.st[1] = nx; }
        const unsigned old = xb_add(&bar[XB_XSUB(b.x)], 1u);
        const unsigned gen = old / nloc;
        if (old + 1u == (gen + 1u) * nloc) {
            __builtin_amdgcn_fence(__ATOMIC_RELEASE, "agent");
            asm volatile("s_waitcnt vmcnt(0)" ::: "memory");
            const unsigned og = xb_add(&bar[XB_TOP], 1u);
            const unsigned tg = og / nx;
            if (og + 1u == (tg + 1u) * nx) xb_add(&bar[XB_TOPGEN], 1u);
            else XB_SPIN(xb_ld(&bar[XB_TOPGEN]) == tg, bar);
            __builtin_amdgcn_fence(__ATOMIC_ACQUIRE, "agent");
            xb_add(&bar[XB_XGEN(b.x)], 1u);
            asm volatile("s_waitcnt vmcnt(0)" ::: "memory");
        } else {
            XB_SPIN(xb_ld(&bar[XB_XGEN(b.x)]) == gen, bar);
            __builtin_amdgcn_fence(__ATOMIC_ACQUIRE, "agent");
            asm volatile("s_waitcnt vmcnt(0)" ::: "memory");
        }
    }
    __syncthreads();
}

struct Args { const float* in[16]; float* out; unsigned char* ws; };
#define PHASE_BEGIN() \
    const __attribute__((address_space(4))) Args* ap = (const __attribute__((address_space(4))) Args*)__builtin_amdgcn_kernarg_segment_ptr(); asm volatile("" : "+s"(ap)); \
    unsigned char* ws = ap->ws; int tid = threadIdx.x; asm volatile("" : "+v"(tid)); \
    const int lane = tid & 63, wave = __builtin_amdgcn_readfirstlane(tid >> 6); const int G = gridDim.x, bx = blockIdx.x; const int gw = bx * 8 + wave, NGW = G * 8; \
    (void)lane; (void)gw; (void)NGW; (void)ws
__global__ void __launch_bounds__(NTHREADS, 2) hymba_fwd(Args args) {
    extern __shared__ __attribute__((aligned(16))) unsigned char lds_raw[];
    LAS unsigned char* lds = (LAS unsigned char*)lds_raw;
    cg::grid_group grid = cg::this_grid();
    XcdBarrier xbar;
    { volatile LAS unsigned* MISC = (volatile LAS unsigned*)(lds + 131072 + 512);
      if (threadIdx.x < 64) MISC[threadIdx.x] = 0u;
      __syncthreads();
      const __attribute__((address_space(4))) Args* ap0 = (const __attribute__((address_space(4))) Args*)__builtin_amdgcn_kernarg_segment_ptr();
      xbar = xcd_barrier_post((unsigned*)ap0->ws, MISC + 8); }
    {
        PHASE_BEGIN();
        const float* x = ap->in[0]; const float* w_in = ap->in[1]; const float* w_out = ap->in[5];
        const float* f1gu = ap->in[6]; const float* f1d = ap->in[7]; const float* f2gu = ap->in[8]; const float* f2d = ap->in[9];
        bf16 *W1GU = (bf16*)(ws + WS_W1GU), *W1D = (bf16*)(ws + WS_W1D), *WIN = (bf16*)(ws + WS_WIN), *WOUT = (bf16*)(ws + WS_WOUT), *W2GU = (bf16*)(ws + WS_W2GU), *W2D = (bf16*)(ws + WS_W2D);
        bf16* XB = (bf16*)(ws + WS_XB);
        LAS float* scr = (LAS float*)(lds + wave * 16384);
        constexpr int I_GU = (D / 64) * (2 * FF / 32), I_D = (FF / 64) * (D / 32), I_IN = (D / 64) * (NIN / 32), I_OUT = (D / 64) * (D / 32);
        constexpr int NITEMS = 2 * I_GU + 2 * I_D + I_IN + I_OUT;
        for (int it = gw; it < NITEMS; it += NGW) {
            int r = it;
            if (r < I_GU) { transpose_item(f1gu, D, 2 * FF, 2 * FF, W1GU, scr, r, lane, MapGU()); continue; } r -= I_GU;
            if (r < I_GU) { transpose_item(f2gu, D, 2 * FF, 2 * FF, W2GU, scr, r, lane, MapGU()); continue; } r -= I_GU;
            if (r < I_D) { transpose_item(f1d, FF, D, D, W1D, scr, r, lane, MapId()); continue; } r -= I_D;
            if (r < I_D) { transpose_item(f2d, FF, D, D, W2D, scr, r, lane, MapId()); continue; } r -= I_D;
            if (r < I_IN) { transpose_item(w_in, D, IN_TOTAL, NIN, WIN, scr, r, lane, MapIn()); continue; } r -= I_IN;
            transpose_item(w_out, D, D, D, WOUT, scr, r, lane, MapId());
        }
        const size_t n8 = (size_t)M * D / 8;
        for (size_t i = (size_t)bx * NTHREADS + tid; i < n8; i += (size_t)G * NTHREADS) {
            const f32x4 a = ((const f32x4*)x)[2 * i], c = ((const f32x4*)x)[2 * i + 1];
            ((u32x4*)XB)[i] = (u32x4){pk2(a.x, a.y), pk2(a.z, a.w), pk2(c.x, c.y), pk2(c.z, c.w)};
        }
    }
    grid.sync();
    { PHASE_BEGIN(); pg8::Gemm g{(bf16*)(ws + WS_XB), (bf16*)(ws + WS_W1GU), M, 2 * FF, D}; pg8::StaticOrder S; S.init(M, 2 * FF, G, bx); pg8::EpiSwiglu E{(bf16*)(ws + WS_H), FF};
      pg8::gemm_phase<pg8::EpiSwiglu, pg8::StaticOrder, true, true>(lds, g, S, E); }
    xcd_barrier(xbar);
    { PHASE_BEGIN(); pg8::Gemm g{(bf16*)(ws + WS_H), (bf16*)(ws + WS_W1D), M, D, FF}; pg8::StaticOrder S; S.init(M, D, G, bx); pg8::EpiResF32 E{ap->in[0], (float*)(ws + WS_Y), D, ALPHA, 0.5f};
      pg8::gemm_phase<pg8::EpiResF32, pg8::StaticOrder, true, true>(lds, g, S, E); }
    xcd_barrier(xbar);
    { PHASE_BEGIN(); ln_rows((const float*)(ws + WS_Y), ap->in[10], ap->in[11], (float*)nullptr, (bf16*)(ws + WS_XB), gw, NGW, lane); }
    xcd_barrier(xbar);
    { PHASE_BEGIN(); pg8::Gemm g{(bf16*)(ws + WS_XB), (bf16*)(ws + WS_WIN), M, NIN, D}; pg8::StaticOrder S; S.init(M, NIN, G, bx); pg8::EpiProj E{(bf16*)(ws + WS_P), NIN, (float*)(ws + WS_PM), NIN / 256 - 1};
      pg8::gemm_phase<pg8::EpiProj, pg8::StaticOrder, true, true>(lds, g, S, E); }
    xcd_barrier(xbar);
    { PHASE_BEGIN();
      for (int it = bx; it < NB * 4 * 64; it += G) gla_g1_item(lds, (const bf16*)(ws + WS_P), (const float*)(ws + WS_PM), ap->in[2], ap->in[3], (float*)(ws + WS_U), (float*)(ws + WS_G), it, tid);
      for (int it = bx; it < NB * 64; it += G) vt_item(lds, (bf16*)(ws + WS_P), it, tid); }
    xcd_barrier(xbar);
    { PHASE_BEGIN(); float* U = (float*)(ws + WS_U); const float* GD = (const float*)(ws + WS_G);
      const int gt = bx * NTHREADS + tid;
      if (gt < NB * 4 * 4096) { const int bh = gt >> 12, e2 = (gt & 4095) * 2, d = e2 & 63; float s0 = 0.f, s1 = 0.f;
#pragma unroll 4
          for (int n = 0; n < 64; ++n) { const int item = bh * 64 + n; float* up = U + (size_t)item * 8192 + e2;
              const float u0 = up[0], u1 = up[1], g0 = GD[item * 64 + d], g1 = GD[item * 64 + d + 1];
              up[0] = s0; up[1] = s1; s0 = g0 * s0 + u0; s1 = g1 * s1 + u1; } } }
    xcd_barrier(xbar);
    { PHASE_BEGIN();
      for (int it = bx; it < NB * 4 * 64; it += G) gla_g3_item(lds, (const bf16*)(ws + WS_P), (const float*)(ws + WS_PM), ap->in[2], ap->in[3], ap->in[4], (const float*)(ws + WS_U), (bf16*)(ws + WS_O), it, tid); }
    xcd_barrier(xbar);
    { PHASE_BEGIN();
      float* scr = ap->out + ((size_t)bx * 8 + wave) * 16384;
      for (int pi = bx; pi < NB * 32; pi += G) { const int b = pi & 7, c1 = pi >> 3;
          dsa_item(lds, (const bf16*)(ws + WS_P), (const float*)(ws + WS_PM), (bf16*)(ws + WS_O), scr, b, 63 - c1, tid);
          dsa_item(lds, (const bf16*)(ws + WS_P), (const float*)(ws + WS_PM), (bf16*)(ws + WS_O), scr, b, c1, tid); } }
    xcd_barrier(xbar);
    { PHASE_BEGIN(); pg8::Gemm g{(bf16*)(ws + WS_O), (bf16*)(ws + WS_WOUT), M, D, D}; pg8::StaticOrder S; S.init(M, D, G, bx); pg8::EpiResBf16 E{(const bf16*)(ws + WS_XB), (float*)(ws + WS_Y), D, ALPHA, 1.0f};
      pg8::gemm_phase<pg8::EpiResBf16, pg8::StaticOrder, true, true>(lds, g, S, E); }
    xcd_barrier(xbar);
    { PHASE_BEGIN(); ln_rows((const float*)(ws + WS_Y), ap->in[12], ap->in[13], (float*)nullptr, (bf16*)(ws + WS_XB), gw, NGW, lane); }
    xcd_barrier(xbar);
    { PHASE_BEGIN(); pg8::Gemm g{(bf16*)(ws + WS_XB), (bf16*)(ws + WS_W2GU), M, 2 * FF, D}; pg8::StaticOrder S; S.init(M, 2 * FF, G, bx); pg8::EpiSwiglu E{(bf16*)(ws + WS_H), FF};
      pg8::gemm_phase<pg8::EpiSwiglu, pg8::StaticOrder, true, true>(lds, g, S, E); }
    xcd_barrier(xbar);
    { PHASE_BEGIN(); pg8::Gemm g{(bf16*)(ws + WS_H), (bf16*)(ws + WS_W2D), M, D, FF}; pg8::StaticOrder S; S.init(M, D, G, bx); pg8::EpiResBf16 E{(const bf16*)(ws + WS_XB), (float*)(ws + WS_Y), D, ALPHA, 0.5f};
      pg8::gemm_phase<pg8::EpiResBf16, pg8::StaticOrder, true, true>(lds, g, S, E); }
    xcd_barrier(xbar);
    { PHASE_BEGIN(); ln_rows((const float*)(ws + WS_Y), ap->in[14], ap->in[15], ap->out, (bf16*)nullptr, gw, NGW, lane); }
}

extern "C" void kernel_launch(void* const* d_in, const int* in_sizes, int n_in, void* d_out, int out_size, void* d_ws, size_t ws_size, hipStream_t stream) {
    static int grid = 0;
    if (grid == 0) {
        if (n_in != 16 || in_sizes[0] != M * D || out_size != M * D || ws_size < WS_END) { fprintf(stderr, "kernel_launch: unexpected shapes (n_in %d, in0 %d, out %d, ws %zu)\n", n_in, n_in > 0 ? in_sizes[0] : -1, out_size, ws_size); grid = -1; return; }
        int dev = 0, cus = 0, per_cu = 0;
        hipGetDevice(&dev); hipDeviceGetAttribute(&cus, hipDeviceAttributeMultiprocessorCount, dev);
        if (hipFuncSetAttribute((const void*)hymba_fwd, hipFuncAttributeMaxDynamicSharedMemorySize, LDS_BYTES) != hipSuccess) { fprintf(stderr, "kernel_launch: hipFuncSetAttribute failed\n"); grid = -1; return; }
        if (hipOccupancyMaxActiveBlocksPerMultiprocessor(&per_cu, (const void*)hymba_fwd, NTHREADS, LDS_BYTES) != hipSuccess || per_cu < 1) { fprintf(stderr, "kernel_launch: occupancy query says %d blocks per CU\n", per_cu); per_cu = 1; }
        (void)hipGetLastError();
        grid = cus;
    }
    if (grid < 0) return;
    if (hipMemsetAsync(d_ws, 0, 16384, stream) != hipSuccess) { fprintf(stderr, "kernel_launch: memset of the barrier words failed\n"); return; }
    Args a{};
    for (int i = 0; i < 16; ++i) a.in[i] = (const float*)d_in[i];
    a.out = (float*)d_out; a.ws = (unsigned char*)d_ws;
    void* kargs[] = {&a};
    hipError_t e = hipLaunchCooperativeKernel((const void*)hymba_fwd, dim3(grid), dim3(NTHREADS), kargs, LDS_BYTES, stream);
    if (e != hipSuccess) fprintf(stderr, "kernel_launch: cooperative launch failed: %s (grid %d)\n", hipGetErrorString(e), grid);
}
```
